# Optimizing an MI355X kernel written in HIP

```python
import math
import jax, jax.numpy as jnp
from jax import lax
import numpy as np

D_MODEL = 1024
BATCH = 8
SEQ = 4096
DEPTH = 4

CTX_LEN = 256
GRID_W = 64
N_MIXERS = 4
N_SUB = 3
N_MOD = 3 * N_SUB
D_FF = 2816
RMS_EPS = 1e-6
NEG_INF = -1e30
ROPE_BASE = 10000.0

S5_GROUP = 16
S5_GROUPS = D_MODEL // S5_GROUP
S5_STATE = 64
S5_DT_MIN = 1e-3
S5_DT_MAX = 1e-1

DIFF_HEAD_DIM = 64
DIFF_HEADS = D_MODEL // (2 * DIFF_HEAD_DIM)
Q_BLOCK = 128

NA_HEADS = 16
NA_HEAD_DIM = D_MODEL // NA_HEADS
WIN_H = 8
WIN_W = 16

HG_EXPAND = 128
HG_HEADS = D_MODEL // HG_EXPAND
HG_CHUNK = 64

kernel_name = "hybrid_s5_diffattn_natten_hgrn2_macaron_dit"

f32 = jnp.float32


def rms_norm(x, gain):
    xf = x.astype(f32)
    xf = xf * lax.rsqrt(jnp.mean(jnp.square(xf), axis=-1, keepdims=True) + RMS_EPS)
    return (xf * gain.astype(f32)).astype(x.dtype)


def modulate(h, shift, scale):
    return h * (1 + scale) + shift


def pre_norm(h, g, mod):
    shift, scale, _ = mod
    return modulate(rms_norm(h, g), shift, scale)


def post_residual(h, y, g, mod, weight):
    return h + weight * mod[2] * rms_norm(y, g)


def swiglu(h, w1, w3, w2):
    return (jax.nn.silu(h @ w1) * (h @ w3)) @ w2


def half_ffn(h, g_in, g_out, mod, w1, w3, w2):
    y = swiglu(pre_norm(h, g_in, mod), w1, w3, w2)
    return post_residual(h, y, g_out, mod, 0.5)


def axial_rope(n_tokens, head_dim):
    n_freq = head_dim // 4
    inv_freq = ROPE_BASE ** (-jnp.arange(n_freq, dtype=f32) / n_freq)
    t = jnp.arange(n_tokens)
    row = (t // GRID_W).astype(f32)
    col = (t % GRID_W).astype(f32)
    ang = jnp.concatenate([row[:, None] * inv_freq, col[:, None] * inv_freq], axis=-1)
    return jnp.cos(ang), jnp.sin(ang)


def apply_rope(x, cos, sin):
    xp = x.astype(f32).reshape(x.shape[:-1] + (-1, 2))
    x1, x2 = xp[..., 0], xp[..., 1]
    out = jnp.stack([x1 * cos - x2 * sin, x1 * sin + x2 * cos], axis=-1)
    return out.reshape(x.shape).astype(x.dtype)


def lti_scan(lam_bar, bu, h0):
    if h0 is not None:
        bu = bu.at[0].add(lam_bar * h0)
    a = jnp.broadcast_to(lam_bar, (bu.shape[0], 1) + lam_bar.shape)

    def combine(left, right):
        a1, b1 = left
        a2, b2 = right
        return a1 * a2, a2 * b1 + b2

    _, h = lax.associative_scan(combine, (a, bu), axis=0)
    return h


def s5_mixer(h_lat, h_ctx, a_re, a_im, log_dt, b_re, b_im, c_re, c_im, d_skip, w_glu, b_glu, ctx_out):
    B, S, D = h_lat.shape
    L = h_ctx.shape[1]
    G, N = S5_GROUPS, S5_GROUP
    u_l = h_lat.astype(f32).reshape(B, S, G, N)
    u_c = h_ctx.astype(f32).reshape(B, L, G, N)
    d_vec = d_skip.astype(f32)
    y_l = d_vec * h_lat.astype(f32)
    y_c = d_vec * h_ctx.astype(f32) if ctx_out else None
    for dirn in range(2):
        flip = (lambda a: jnp.flip(a, axis=0)) if dirn else (lambda a: a)
        lam = lax.complex(a_re[dirn].astype(f32), a_im[dirn].astype(f32))
        dt = jnp.exp(log_dt[dirn].astype(f32))[:, None]
        lam_bar = jnp.exp(lam * dt)
        b_bar = ((lam_bar - 1) / lam)[:, :, None] * lax.complex(b_re[dirn].astype(f32), b_im[dirn].astype(f32))
        c_mat = lax.complex(c_re[dirn].astype(f32), c_im[dirn].astype(f32))
        h_c = lti_scan(lam_bar, flip(jnp.einsum('gpn,btgn->tbgp', b_bar, u_c)), None)
        h_l = lti_scan(lam_bar, flip(jnp.einsum('gpn,btgn->tbgp', b_bar, u_l)), h_c[-1])
        y_l = y_l + jnp.real(jnp.einsum('gnp,tbgp->btgn', c_mat, flip(h_l))).reshape(B, S, D)
        if ctx_out:
            y_c = y_c + jnp.real(jnp.einsum('gnp,tbgp->btgn', c_mat, flip(h_c))).reshape(B, L, D)
    w = w_glu.astype(f32)
    bb = b_glu.astype(f32)

    def glu(y):
        z = jax.nn.gelu(y)
        return (z * jax.nn.sigmoid(z @ w + bb)).astype(h_lat.dtype)

    return glu(y_l), (glu(y_c) if ctx_out else None)


def diff_attention(h_lat, h_ctx, w_qkv, w_o, lam_q1, lam_k1, lam_q2, lam_k2, subln_g, layer_idx, ctx_out):
    B, S, D = h_lat.shape
    H, d = DIFF_HEADS, DIFF_HEAD_DIM
    lam_init = 0.8 - 0.6 * math.exp(-0.3 * layer_idx)
    lam = (jnp.exp(jnp.sum(lam_q1.astype(f32) * lam_k1.astype(f32)))
           - jnp.exp(jnp.sum(lam_q2.astype(f32) * lam_k2.astype(f32))) + lam_init)

    def project(h):
        T = h.shape[1]
        q, k, v = jnp.split(h @ w_qkv, 3, axis=-1)
        q = q.reshape(B, T, H, 2, d).transpose(0, 2, 3, 1, 4)
        k = k.reshape(B, T, H, 2, d).transpose(0, 2, 3, 1, 4)
        v = v.reshape(B, T, H, 2 * d).transpose(0, 2, 1, 3)
        return q, k, v

    def mix(q, k, v):
        s = jnp.einsum('bhmqd,bhmkd->bhmqk', q, k).astype(f32) * (d ** -0.5)
        p = jax.nn.softmax(s, axis=-1)
        a = p[:, :, 0] - lam * p[:, :, 1]
        return jnp.einsum('bhqk,bhkd->bhqd', a.astype(v.dtype), v)

    def readout(o):
        T = o.shape[2]
        o = rms_norm(o, subln_g) * (1 - lam_init)
        return o.transpose(0, 2, 1, 3).reshape(B, T, D) @ w_o

    q_c, k_c, v_c = project(h_ctx)
    q_l, k_l, v_l = project(h_lat)
    cos, sin = axial_rope(S, d)
    q_l = apply_rope(q_l, cos, sin)
    k_l = apply_rope(k_l, cos, sin)
    k_all = jnp.concatenate([k_c, k_l], axis=3)
    v_all = jnp.concatenate([v_c, v_l], axis=2)
    n_blk = S // Q_BLOCK
    q_blocks = jnp.moveaxis(q_l.reshape(B, H, 2, n_blk, Q_BLOCK, d), 3, 0)
    o_l = lax.map(lambda qb: mix(qb, k_all, v_all), q_blocks)
    o_l = jnp.moveaxis(o_l, 0, 2).reshape(B, H, S, 2 * d)
    y_ctx = readout(mix(q_c, k_c, v_c)) if ctx_out else None
    return readout(o_l), y_ctx


def neighbourhood_attention(h_lat, h_ctx, w_qkv, w_o, rpb, ctx_out):
    B, S, D = h_lat.shape
    L = h_ctx.shape[1]
    H, d = NA_HEADS, NA_HEAD_DIM
    rows = S // GRID_W
    kh = min(WIN_H, rows)
    scale = d ** -0.5

    def project(h):
        T = h.shape[1]
        qkv = (h @ w_qkv).reshape(B, T, 3, H, d).transpose(2, 0, 3, 1, 4)
        return qkv[0], qkv[1], qkv[2]

    q_c, k_c, v_c = project(h_ctx)
    q_l, k_l, v_l = project(h_lat)
    q_l, k_l, v_l = [a.reshape(B, H, rows, GRID_W, d) for a in (q_l, k_l, v_l)]

    col = jnp.arange(GRID_W)
    c0 = jnp.clip(col - WIN_W // 2, 0, GRID_W - WIN_W)
    col_mask = (col[None, :] >= c0[:, None]) & (col[None, :] < c0[:, None] + WIN_W)
    dc_idx = jnp.clip(col[None, :] - col[:, None] + WIN_W - 1, 0, 2 * WIN_W - 2)
    rpb_cols = rpb.astype(f32)[:, :, dc_idx]

    def row_block(r):
        r0 = jnp.clip(r - kh // 2, 0, rows - kh)
        q_r = lax.dynamic_index_in_dim(q_l, r, axis=2, keepdims=False)
        k_b = lax.dynamic_slice_in_dim(k_l, r0, kh, axis=2)
        v_b = lax.dynamic_slice_in_dim(v_l, r0, kh, axis=2).reshape(B, H, kh * GRID_W, d)
        dr_idx = r0 + jnp.arange(kh) - r + WIN_H - 1
        bias = rpb_cols[:, dr_idx].transpose(0, 2, 1, 3)
        s_lat = jnp.einsum('bhqd,bhrkd->bhqrk', q_r, k_b).astype(f32) * scale + bias[None]
        s_lat = jnp.where(col_mask[:, None, :], s_lat, NEG_INF).reshape(B, H, GRID_W, kh * GRID_W)
        s_ctx = jnp.einsum('bhqd,bhkd->bhqk', q_r, k_c).astype(f32) * scale
        p = jax.nn.softmax(jnp.concatenate([s_ctx, s_lat], axis=-1), axis=-1)
        return (jnp.einsum('bhqk,bhkd->bhqd', p[..., :L].astype(v_c.dtype), v_c)
                + jnp.einsum('bhqk,bhkd->bhqd', p[..., L:].astype(v_b.dtype), v_b))

    o_l = lax.map(row_block, jnp.arange(rows))
    y_lat = o_l.transpose(1, 0, 3, 2, 4).reshape(B, S, D) @ w_o
    y_ctx = None
    if ctx_out:
        p = jax.nn.softmax(jnp.einsum('bhqd,bhkd->bhqk', q_c, k_c).astype(f32) * scale, axis=-1)
        o_c = jnp.einsum('bhqk,bhkd->bhqd', p.astype(v_c.dtype), v_c)
        y_ctx = o_c.transpose(0, 2, 1, 3).reshape(B, L, D) @ w_o
    return y_lat, y_ctx


def gla_chunks(q, k, v, log_f, s0, with_output):
    B, H, T, K = k.shape
    V = v.shape[-1]
    C = HG_CHUNK
    n = T // C
    chunk = lambda a: a.reshape(B, H, n, C, a.shape[-1])
    k, v, log_f = chunk(k), chunk(v), chunk(log_f)
    g = jnp.cumsum(log_f, axis=3)
    g_last = g[:, :, :, -1]
    ds = jnp.einsum('bhnck,bhncv->bhnkv', k * jnp.exp(g_last[:, :, :, None] - g), v)

    def step(s, inp):
        decay, ds_n = inp
        return decay[..., None] * s + ds_n, s

    s_last, s_start = lax.scan(step, s0, (jnp.moveaxis(jnp.exp(g_last), 2, 0), jnp.moveaxis(ds, 2, 0)))
    if not with_output:
        return None, s_last
    q = chunk(q)
    q_dec = q * jnp.exp(g)
    k_inv = k * jnp.exp(-g)
    earlier_or_same = jnp.tril(jnp.ones((C, C), bool))
    att = jnp.where(earlier_or_same, jnp.einsum('bhnck,bhnsk->bhncs', q_dec, k_inv), 0.0)
    o = (jnp.einsum('bhncs,bhnsv->bhncv', att, v)
         + jnp.einsum('bhnck,bhnkv->bhncv', q_dec, jnp.moveaxis(s_start, 0, 2)))
    return o.reshape(B, H, T, V), s_last


def hgrn2_mixer(h_lat, h_ctx, w_qig, w_f, b_f, lb, gn_g, w_o, ctx_out):
    B, S, D = h_lat.shape
    L = h_ctx.shape[1]
    H = HG_HEADS
    lb = lb.astype(f32)
    heads = lambda a: a.astype(f32).reshape(B, a.shape[1], H, -1).transpose(0, 2, 1, 3)

    def log_forget(h, dirn):
        z = (h @ w_f[dirn] + b_f[dirn]).astype(f32)
        return heads(jnp.log(lb + (1 - lb) * jax.nn.sigmoid(z)))

    q_l, i_l, g_l = jnp.split(h_lat @ w_qig, 3, axis=-1)
    q_l, i_l = heads(q_l), heads(i_l)
    if ctx_out:
        q_c, i_c, g_c = jnp.split(h_ctx @ w_qig, 3, axis=-1)
        q_c = heads(q_c)
    else:
        i_c = h_ctx @ w_qig[:, D:2 * D]
    i_c = heads(i_c)
    s0 = jnp.zeros((B, H, HG_EXPAND, D // H), f32)
    o_l = 0.0
    o_c = 0.0
    for dirn in range(2):
        flip = (lambda a: jnp.flip(a, axis=2)) if dirn else (lambda a: a)
        lf_c = log_forget(h_ctx, dirn)
        lf_l = log_forget(h_lat, dirn)
        oc, s_c = gla_chunks(flip(q_c) if ctx_out else None, flip(-jnp.expm1(lf_c)), flip(i_c),
                             flip(lf_c), s0, ctx_out)
        ol, _ = gla_chunks(flip(q_l), flip(-jnp.expm1(lf_l)), flip(i_l), flip(lf_l), s_c, True)
        o_l = o_l + flip(ol)
        if ctx_out:
            o_c = o_c + flip(oc)

    def readout(o, gate):
        T = o.shape[2]
        o = rms_norm(o, gn_g).transpose(0, 2, 1, 3).reshape(B, T, D)
        return (o * jax.nn.silu(gate.astype(f32))).astype(h_lat.dtype) @ w_o

    return readout(o_l, g_l), (readout(o_c, g_c) if ctx_out else None)


def setup_inputs(seed: int = 0) -> dict:
    key = jax.random.key(seed)
    keys = iter(jax.random.split(key, 64))

    def nrm(shape, scale):
        return scale * jax.random.normal(next(keys), shape, f32)

    def gain(shape):
        return 1.0 + 0.02 * jax.random.normal(next(keys), shape, f32)

    nA, nB, nC, nD = [len(range(m, DEPTH, N_MIXERS)) for m in range(N_MIXERS)]
    D = D_MODEL
    G, N, P = S5_GROUPS, S5_GROUP, S5_STATE
    sd = D ** -0.5
    n_idx = jnp.arange(P, dtype=f32)
    return {
        'x': nrm((BATCH, SEQ, D), 1.0),
        'c': nrm((BATCH, D), 1.0),
        'ctx': nrm((BATCH, CTX_LEN, D), 1.0),
        'c_ctx': nrm((D,), 1.0),
        'w_ada': nrm((DEPTH, D, N_MOD * D), sd),
        'b_ada': nrm((DEPTH, N_MOD * D), 0.02),
        'g_pre': gain((DEPTH, N_SUB, D)),
        'g_post': gain((DEPTH, N_SUB, D)),
        'w_ff1': nrm((DEPTH, 2, D, D_FF), sd),
        'w_ff3': nrm((DEPTH, 2, D, D_FF), sd),
        'w_ff2': nrm((DEPTH, 2, D_FF, D), D_FF ** -0.5),
        's5_a_re': -0.5 * gain((nA, 2, G, P)),
        's5_a_im': math.pi * n_idx + nrm((nA, 2, G, P), 0.01),
        's5_log_dt': jax.random.uniform(next(keys), (nA, 2, G), f32,
                                        minval=math.log(S5_DT_MIN), maxval=math.log(S5_DT_MAX)),
        's5_b_re': nrm((nA, 2, G, P, N), (2 * N) ** -0.5),
        's5_b_im': nrm((nA, 2, G, P, N), (2 * N) ** -0.5),
        's5_c_re': nrm((nA, 2, G, N, P), (2 * P) ** -0.5),
        's5_c_im': nrm((nA, 2, G, N, P), (2 * P) ** -0.5),
        's5_d': nrm((nA, D), 1.0),
        's5_w_glu': nrm((nA, D, D), sd),
        's5_b_glu': nrm((nA, D), 0.02),
        'da_w_qkv': nrm((nB, D, 3 * D), sd),
        'da_w_o': nrm((nB, D, D), sd),
        'da_lam_q1': nrm((nB, DIFF_HEAD_DIM), 0.1),
        'da_lam_k1': nrm((nB, DIFF_HEAD_DIM), 0.1),
        'da_lam_q2': nrm((nB, DIFF_HEAD_DIM), 0.1),
        'da_lam_k2': nrm((nB, DIFF_HEAD_DIM), 0.1),
        'da_subln': gain((nB, 2 * DIFF_HEAD_DIM)),
        'na_w_qkv': nrm((nC, D, 3 * D), sd),
        'na_w_o': nrm((nC, D, D), sd),
        'na_rpb': nrm((nC, NA_HEADS, 2 * WIN_H - 1, 2 * WIN_W - 1), 0.02),
        'hg_w_qig': nrm((nD, D, 3 * D), sd),
        'hg_w_f': nrm((nD, 2, D, D), sd),
        'hg_b_f': nrm((nD, 2, D), 0.1),
        'hg_lb_logits': nrm((DEPTH, D), 0.1),
        'hg_gnorm': gain((nD, D // HG_HEADS)),
        'hg_w_o': nrm((nD, D, D), sd),
    }


def reference(x, c, ctx, c_ctx, w_ada, b_ada, g_pre, g_post, w_ff1, w_ff3, w_ff2,
              s5_a_re, s5_a_im, s5_log_dt, s5_b_re, s5_b_im, s5_c_re, s5_c_im, s5_d, s5_w_glu, s5_b_glu,
              da_w_qkv, da_w_o, da_lam_q1, da_lam_k1, da_lam_q2, da_lam_k2, da_subln,
              na_w_qkv, na_w_o, na_rpb,
              hg_w_qig, hg_w_f, hg_b_f, hg_lb_logits, hg_gnorm, hg_w_o):
    B, S, D = x.shape
    lb_p = jax.nn.softmax(hg_lb_logits.astype(f32), axis=0)
    lower_bounds = jnp.cumsum(lb_p, axis=0) - lb_p[0]
    silu_c = jax.nn.silu(c)
    silu_cc = jax.nn.silu(c_ctx)
    x_lat, x_ctx = x, ctx
    for i in range(DEPTH):
        last = i == DEPTH - 1
        occ = i // N_MIXERS
        kind = i % N_MIXERS
        m_lat = (silu_c @ w_ada[i] + b_ada[i]).reshape(B, N_SUB, 3, 1, D)
        m_ctx = (silu_cc @ w_ada[i] + b_ada[i]).reshape(N_SUB, 3, D)
        lat_mod = [(m_lat[:, j, 0], m_lat[:, j, 1], m_lat[:, j, 2]) for j in range(N_SUB)]
        ctx_mod = [(m_ctx[j, 0], m_ctx[j, 1], m_ctx[j, 2]) for j in range(N_SUB)]

        x_lat = half_ffn(x_lat, g_pre[i, 0], g_post[i, 0], lat_mod[0], w_ff1[i, 0], w_ff3[i, 0], w_ff2[i, 0])
        x_ctx = half_ffn(x_ctx, g_pre[i, 0], g_post[i, 0], ctx_mod[0], w_ff1[i, 0], w_ff3[i, 0], w_ff2[i, 0])

        h_lat = pre_norm(x_lat, g_pre[i, 1], lat_mod[1])
        h_ctx = pre_norm(x_ctx, g_pre[i, 1], ctx_mod[1])
        if kind == 0:
            y_lat, y_ctx = s5_mixer(h_lat, h_ctx, s5_a_re[occ], s5_a_im[occ], s5_log_dt[occ], s5_b_re[occ],
                                    s5_b_im[occ], s5_c_re[occ], s5_c_im[occ], s5_d[occ], s5_w_glu[occ],
                                    s5_b_glu[occ], not last)
        elif kind == 1:
            y_lat, y_ctx = diff_attention(h_lat, h_ctx, da_w_qkv[occ], da_w_o[occ], da_lam_q1[occ], da_lam_k1[occ],
                                          da_lam_q2[occ], da_lam_k2[occ], da_subln[occ], i, not last)
        elif kind == 2:
            y_lat, y_ctx = neighbourhood_attention(h_lat, h_ctx, na_w_qkv[occ], na_w_o[occ], na_rpb[occ], not last)
        else:
            y_lat, y_ctx = hgrn2_mixer(h_lat, h_ctx, hg_w_qig[occ], hg_w_f[occ], hg_b_f[occ], lower_bounds[i],
                                       hg_gnorm[occ], hg_w_o[occ], not last)
        x_lat = post_residual(x_lat, y_lat, g_post[i, 1], lat_mod[1], 1.0)

        x_lat = half_ffn(x_lat, g_pre[i, 2], g_post[i, 2], lat_mod[2], w_ff1[i, 1], w_ff3[i, 1], w_ff2[i, 1])
        if not last:
            x_ctx = post_residual(x_ctx, y_ctx, g_post[i, 1], ctx_mod[1], 1.0)
            x_ctx = half_ffn(x_ctx, g_pre[i, 2], g_post[i, 2], ctx_mod[2], w_ff1[i, 1], w_ff3[i, 1], w_ff2[i, 1])
    return x_lat
```

```cpp
#include <hip/hip_runtime.h>
#include <hip/hip_cooperative_groups.h>
#include <cstdio>
#include <cstdint>
namespace cg = cooperative_groups;
namespace pg8 {
#define PG8_LAS __attribute__((address_space(3)))
typedef unsigned short bf16_t;
typedef short bf16x8 __attribute__((ext_vector_type(8)));
typedef float f32x4 __attribute__((ext_vector_type(4)));
typedef unsigned u32x4 __attribute__((ext_vector_type(4)));
constexpr int BM = 256, BK = 64, HALF = 128, HTB = HALF * BK * 2  , STAGE_BYTES = 8 * HTB, NXCD = 8, WGM = 8;

__host__ __device__ __forceinline__ int lds_byte(int r, int c) { const int st = (r >> 4) * 2 + (c >> 5), rr = r & 15, cc = c & 31, ob = rr * 64 + cc * 2; return st * 1024 + (ob ^ (((ob >> 9) & 1) << 5)); }
__host__ __device__ __forceinline__ void stage_rc(int b, int& R, int& C) { const int st = b / 1024, sb = b % 1024, swz = sb ^ (((sb >> 9) & 1) << 5); R = (st >> 1) * 16 + swz / 64; C = (st & 1) * 32 + (swz % 64) / 2; }
__host__ __device__ __forceinline__ int perm32(int rho) { const int n = rho >> 4, i = rho & 15; return 8 * (i >> 2) + 4 * n + (i & 3); }

struct Unit { int pm, pn, kb, nkt, part; };
struct Gemm { const bf16_t* A; const bf16_t* Bt; int M, N, K; };

struct StaticOrder {
    int nM, nN, nwg, G, c;
    int nktf, P, nsp, pm0;
    __host__ __device__ void init(int M, int N, int G_, int c_, int K_, int P_ = 0, int nsp_ = 0, int pm0_ = 0) { nM = M / BM; nN = N / BM; nwg = nM * nN; G = G_; c = c_; nktf = K_ / BK; P = P_; nsp = nsp_; pm0 = pm0_; }
    __host__ __device__ __forceinline__ bool next(int i, Unit& u) const {
        const long L = (long)i * G + c; if (L >= nwg + nsp * P) return false;
        const bool sp = (L >= nwg);
        const int Pd = P > 0 ? P : 1; const int v = sp ? (int)L - nwg : 0, cu = v / Pd, p = v - cu * Pd;
        int wgid = sp ? 0 : (int)L; { const int q = nwg / NXCD, r = nwg % NXCD, xcd = wgid % NXCD, off = wgid / NXCD; wgid = (xcd < r ? xcd * (q + 1) : r * (q + 1) + (xcd - r) * q) + off; }
        const int nig = WGM * nN, gid = wgid / nig, fm = gid * WGM, gsz = (nM - fm) < WGM ? (nM - fm) : WGM;
        const int pm_n = fm + ((wgid % nig) % gsz), pn_n = (wgid % nig) / gsz;
        const int nk_s = nktf / Pd;
        u.pm = sp ? pm0 + cu / nN : pm_n; u.pn = sp ? cu % nN : pn_n; u.nkt = sp ? nk_s : nktf; u.kb = sp ? p * nk_s : 0; u.part = sp ? p : -1;
        return true;
    }
    __device__ __forceinline__ void a_ready(const Unit&) const {}
    __device__ __forceinline__ void done(const Unit&) const {}
};
typedef float f32x2_cv __attribute__((ext_vector_type(2))); typedef __bf16 bf16x2_cv __attribute__((ext_vector_type(2)));
__device__ __forceinline__ unsigned cvt_pk_bf16(float lo, float hi) { f32x2_cv v = {lo, hi}; bf16x2_cv b = __builtin_convertvector(v, bf16x2_cv); return __builtin_bit_cast(unsigned, b); }
typedef unsigned u32x2 __attribute__((ext_vector_type(2)));
#define PG8_GAS __attribute__((address_space(1)))
__device__ __forceinline__ float fast_sigmoid(float x) { return __builtin_amdgcn_rcpf(1.0f + __builtin_amdgcn_exp2f(-1.4426950408889634f * x)); }
__device__ __forceinline__ float bf2f(unsigned short b) { return __uint_as_float(((unsigned)b) << 16); }
constexpr int E_FF = 2816, E_D = 1024, E_TALL = 4352, E_MLAT = 32768;

struct EpiSwiglu {
    static constexpr bool PERM = true, AFTER_DRAIN = false;
    bf16_t* U;
    __device__ __forceinline__ void operator()(const f32x4 (&acc)[2][2][4][2], const Unit& u, int wr, int wc, int fr, int fq) const {
        const int row0 = u.pm * BM + wr * 64 + fr, col0 = u.pn * 128 + wc * 32 + 8 * fq;
#pragma unroll
        for (int ai = 0; ai < 2; ++ai)
#pragma unroll
            for (int m = 0; m < 4; ++m) {
                bf16_t* rowp = U + (size_t)(row0 + ai * HALF + m * 16) * E_FF + col0;
                float r[8];
#pragma unroll
                for (int n = 0; n < 2; ++n)
#pragma unroll
                    for (int j = 0; j < 4; ++j) { const float a = acc[ai][0][m][n][j], g = acc[ai][1][m][n][j]; r[4 * n + j] = a * fast_sigmoid(a) * g; }
                u32x4 w; w.x = cvt_pk_bf16(r[0], r[1]); w.y = cvt_pk_bf16(r[2], r[3]); w.z = cvt_pk_bf16(r[4], r[5]); w.w = cvt_pk_bf16(r[6], r[7]);
                *(u32x4*)rowp = w;
            }
    }
};
struct EpiBf16S {
    static constexpr bool PERM = true, AFTER_DRAIN = false;
    bf16_t *O0, *O1, *O2; const float* bias; bf16_t* OP;
    __device__ __forceinline__ void operator()(const f32x4 (&acc)[2][2][4][2], const Unit& u, int wr, int wc, int fr, int fq) const {
        const int row0 = u.pm * BM + wr * 64 + fr; const int colt = u.pn * BM; const int t = colt >> 10;
        PG8_GAS bf16_t* base = (PG8_GAS bf16_t*)((unsigned long long)O0 + (unsigned long long)(t & 1) * ((unsigned long long)O1 - (unsigned long long)O0) + (unsigned long long)(t >> 1) * ((unsigned long long)O2 - (unsigned long long)O0));
        if (u.part >= 0) base = (PG8_GAS bf16_t*)OP + ((long)u.part * 2048 - (long)E_MLAT) * E_D;
        const int col0 = (colt & 1023) + wc * 32 + 8 * fq, bcol0 = colt + wc * 32 + 8 * fq;
        f32x4 bv[2][2];
#pragma unroll
        for (int bj = 0; bj < 2; ++bj)
#pragma unroll
            for (int n = 0; n < 2; ++n) bv[bj][n] = bias ? *(const f32x4*)(bias + bcol0 + bj * HALF + 4 * n) : (f32x4){0.f, 0.f, 0.f, 0.f};
#pragma unroll
        for (int ai = 0; ai < 2; ++ai)
#pragma unroll
            for (int m = 0; m < 4; ++m) { PG8_GAS bf16_t* rowp = base + (size_t)(row0 + ai * HALF + m * 16) * E_D + col0;
#pragma unroll
                for (int bj = 0; bj < 2; ++bj) { const f32x4 v0 = acc[ai][bj][m][0] + bv[bj][0], v1 = acc[ai][bj][m][1] + bv[bj][1];
                    u32x4 w; w.x = cvt_pk_bf16(v0[0], v0[1]); w.y = cvt_pk_bf16(v0[2], v0[3]); w.z = cvt_pk_bf16(v1[0], v1[1]); w.w = cvt_pk_bf16(v1[2], v1[3]);
                    *(PG8_GAS u32x4*)(rowp + bj * HALF) = w; } }
    }
};
struct EpiGlu {
    static constexpr bool PERM = true, AFTER_DRAIN = false;
    const bf16_t* Z; bf16_t* O; const float* bias;
    __device__ __forceinline__ void operator()(const f32x4 (&acc)[2][2][4][2], const Unit& u, int wr, int wc, int fr, int fq) const {
        const int row0 = u.pm * BM + wr * 64 + fr; const int col0 = u.pn * BM + wc * 32 + 8 * fq;
#pragma unroll
        for (int ai = 0; ai < 2; ++ai)
#pragma unroll
            for (int m = 0; m < 4; ++m) { const size_t ro = (size_t)(row0 + ai * HALF + m * 16) * E_D + col0;
#pragma unroll
                for (int bj = 0; bj < 2; ++bj) {
                    const u32x4 z = *(const u32x4*)(Z + ro + bj * HALF);
                    const f32x4 b0 = *(const f32x4*)(bias + col0 + bj * HALF), b1 = *(const f32x4*)(bias + col0 + bj * HALF + 4);
                    const f32x4 v0 = acc[ai][bj][m][0] + b0, v1 = acc[ai][bj][m][1] + b1;
                    float r[8];
                    const unsigned zz[4] = {z.x, z.y, z.z, z.w};
#pragma unroll
                    for (int j = 0; j < 4; ++j) {
                        const float zl = __uint_as_float(zz[j] << 16), zh = __uint_as_float(zz[j] & 0xffff0000u);
                        const float s0 = fast_sigmoid(j < 2 ? v0[2 * j] : v1[2 * j - 4]), s1 = fast_sigmoid(j < 2 ? v0[2 * j + 1] : v1[2 * j - 3]);
                        r[2 * j] = zl * s0; r[2 * j + 1] = zh * s1; }
                    u32x4 w; w.x = cvt_pk_bf16(r[0], r[1]); w.y = cvt_pk_bf16(r[2], r[3]); w.z = cvt_pk_bf16(r[4], r[5]); w.w = cvt_pk_bf16(r[6], r[7]);
                    *(u32x4*)(O + ro + bj * HALF) = w; } }
    }
};
template <int MODE> struct EpiQKV {
    static constexpr bool PERM = true, AFTER_DRAIN = false;
    bf16_t *Q, *K, *Vt; const float* rcos; const float* rsin;
    __device__ __forceinline__ void operator()(const f32x4 (&acc)[2][2][4][2], const Unit& u, int wr, int wc, int fr, int fq) const {
        const int colt = u.pn * BM; const int sec = colt >> 10;
        const bool lat = (u.pm * BM) < E_MLAT;
#pragma unroll
        for (int ai = 0; ai < 2; ++ai)
#pragma unroll
            for (int m = 0; m < 4; ++m) {
                const int r = u.pm * BM + ai * HALF + wr * 64 + m * 16 + fr;
                int b, t, s;
                if (lat) { b = r >> 12; t = r & 4095; s = 256 + t; } else { const int rr = r - E_MLAT; b = rr >> 8; t = rr & 255; s = t; }
#pragma unroll
                for (int bj = 0; bj < 2; ++bj) {
                    const int cb = (colt & 1023) + bj * HALF + wc * 32 + 8 * fq;
                    float e[8];
#pragma unroll
                    for (int j = 0; j < 4; ++j) { e[j] = acc[ai][bj][m][0][j]; e[4 + j] = acc[ai][bj][m][1][j]; }
                    if (sec < 2) {
                        const int hd = cb >> 6, dd = cb & 63;
                        if (MODE == 0 && lat) {
                            const f32x4 cs = *(const f32x4*)(rcos + t * 32 + (dd >> 1)), sn = *(const f32x4*)(rsin + t * 32 + (dd >> 1));
#pragma unroll
                            for (int j = 0; j < 4; ++j) { const float x1 = e[2 * j], x2 = e[2 * j + 1]; e[2 * j] = x1 * cs[j] - x2 * sn[j]; e[2 * j + 1] = x1 * sn[j] + x2 * cs[j]; }
                        }
                        if (sec == 0) {
#pragma unroll
                            for (int j = 0; j < 8; ++j) e[j] *= 0.125f * 1.4426950408889634f;
                        }
                        bf16_t* dst = (sec ? K : Q) + ((size_t)(b * 16 + hd) * E_TALL + s) * 64 + dd;
                        u32x4 w; w.x = cvt_pk_bf16(e[0], e[1]); w.y = cvt_pk_bf16(e[2], e[3]); w.z = cvt_pk_bf16(e[4], e[5]); w.w = cvt_pk_bf16(e[6], e[7]);
                        *(u32x4*)dst = w;
                    } else {
                        const int vh = (MODE == 0) ? (cb >> 7) : (cb >> 6), dv = (MODE == 0) ? (cb & 127) : (cb & 63);
                        constexpr int NVH = (MODE == 0) ? 8 : 16, DVV = (MODE == 0) ? 128 : 64;
                        bf16_t* dst = Vt + ((size_t)(b * NVH + vh) * DVV + dv) * E_TALL + s;
#pragma unroll
                        for (int j = 0; j < 4; ++j) { const unsigned pk = cvt_pk_bf16(e[2 * j], e[2 * j + 1]); dst[(size_t)(2 * j) * E_TALL] = (bf16_t)(pk & 0xffffu); dst[(size_t)(2 * j + 1) * E_TALL] = (bf16_t)(pk >> 16); }
                    }
                    asm volatile("" ::: "memory");
                }
            }
    }
};
template <class Epi, class Sched, bool ALIGN_EPI = false, bool SP2 = false>
__device__ __forceinline__ void gemm_phase(PG8_LAS unsigned char* lds, const Gemm g, const Sched& S, const Epi& E, const int tid) {
    const int wid = __builtin_amdgcn_readfirstlane(tid >> 6), lane = tid & 63, wr = wid >> 2, wc = wid & 3, fr = lane & 15, fq = lane >> 4;
    const int K = g.K;
    unsigned voffA[2], voffB[2];
#pragma unroll
    for (int i = 0; i < 2; ++i) { int R, C; stage_rc(tid * 16 + i * 8192, R, C); const int Rb = Epi::PERM ? ((R & ~31) + perm32(R & 31)) : R;
        voffA[i] = (unsigned)(R * K + C) * 2u; voffB[i] = (unsigned)(Rb * K + C) * 2u; }
    const size_t kstep = (size_t)(BK * 2);
    const size_t hstep = (size_t)HALF * K * 2;
    const size_t tstep = 2 * hstep;
    const unsigned ldsw = (unsigned)wid * 1024u;
    const int aoff = lds_byte(wr * 64 + fr, fq * 8), boff = lds_byte(wc * 32 + fr, fq * 8);
#define PG8_SA(b, h) (((b) * 2 + (h)) * HTB)
#define PG8_SB(b, h) ((4 + (b) * 2 + (h)) * HTB)
#define PG8_STAGE(bufoff, gbase, voff) do { _Pragma("unroll") for (int _i = 0; _i < 2; ++_i) \
        __builtin_amdgcn_global_load_lds((const unsigned*)((const char*)(gbase) + (voff)[_i]), (PG8_LAS unsigned*)(lds + (bufoff) + ldsw + _i * 8192), 16, 0, 0); } while (0)
#define PG8_LDA(dst, b, h) do { _Pragma("unroll") for (int m = 0; m < 4; ++m) _Pragma("unroll") for (int k = 0; k < 2; ++k) dst[m][k] = *(const PG8_LAS bf16x8*)(lds + PG8_SA(b, h) + aoff + m * 2048 + k * 1024); } while (0)
#define PG8_LDB(dst, b, h) do { _Pragma("unroll") for (int n = 0; n < 2; ++n) _Pragma("unroll") for (int k = 0; k < 2; ++k) dst[n][k] = *(const PG8_LAS bf16x8*)(lds + PG8_SB(b, h) + boff + n * 2048 + k * 1024); } while (0)
#define PG8_MMA(ai, bj, At, Bt) do { __builtin_amdgcn_s_setprio(1); _Pragma("unroll") for (int m = 0; m < 4; ++m) _Pragma("unroll") for (int n = 0; n < 2; ++n) _Pragma("unroll") for (int k = 0; k < 2; ++k) \
        acc[ai][bj][m][n] = __builtin_amdgcn_mfma_f32_16x16x32_bf16(Bt[n][k], At[m][k], acc[ai][bj][m][n], 0, 0, 0); __builtin_amdgcn_s_setprio(0); } while (0)
#define PG8_WAIT_V(n) asm volatile("s_waitcnt vmcnt(" #n ")" ::: "memory")
#define PG8_WAIT_L(n) asm volatile("s_waitcnt lgkmcnt(" #n ")" ::: "memory")
#define PG8_BAR __builtin_amdgcn_s_barrier()
#define PG8_SCHED __builtin_amdgcn_sched_barrier(0)
    Unit cur, nxt; int ui = 0;
    if (!S.next(0, cur)) return;
    f32x4 acc[2][2][4][2];
#pragma unroll
    for (int a = 0; a < 2; ++a)
#pragma unroll
        for (int b = 0; b < 2; ++b)
#pragma unroll
            for (int m = 0; m < 4; ++m)
#pragma unroll
                for (int n = 0; n < 2; ++n) acc[a][b][m][n] = (f32x4){0.f, 0.f, 0.f, 0.f};
    bf16x8 At[4][2], B0[2][2], B1[2][2];
    const char* cA = (const char*)g.A + (size_t)cur.pm * tstep + (size_t)cur.kb * kstep; const char* cB = (const char*)g.Bt + (size_t)cur.pn * tstep + (size_t)cur.kb * kstep;
    S.a_ready(cur);
    if constexpr (SP2) {
        PG8_STAGE(PG8_SB(0, 0), cB, voffB); PG8_STAGE(PG8_SB(0, 1), cB + hstep, voffB); PG8_STAGE(PG8_SA(0, 0), cA, voffA); PG8_STAGE(PG8_SA(0, 1), cA + hstep, voffA);
        if (wr == 1) PG8_BAR;
        PG8_WAIT_V(2); PG8_BAR;
        PG8_STAGE(PG8_SB(1, 0), cB + kstep, voffB); PG8_STAGE(PG8_SA(1, 0), cA + kstep, voffA); PG8_STAGE(PG8_SB(1, 1), cB + hstep + kstep, voffB);
        PG8_WAIT_V(6); PG8_BAR;
    } else {
        PG8_STAGE(PG8_SB(0, 0), cB, voffB); PG8_STAGE(PG8_SA(0, 0), cA, voffA); PG8_STAGE(PG8_SB(0, 1), cB + hstep, voffB); PG8_STAGE(PG8_SA(0, 1), cA + hstep, voffA);
        if (wr == 1) PG8_BAR;
        PG8_WAIT_V(4); PG8_BAR;
        PG8_STAGE(PG8_SB(1, 0), cB + kstep, voffB); PG8_STAGE(PG8_SA(1, 0), cA + kstep, voffA); PG8_STAGE(PG8_SB(1, 1), cB + hstep + kstep, voffB);
        PG8_WAIT_V(6); PG8_BAR;
    }
    for (;;) {
        const bool has_next = S.next(ui + 1, nxt);
        const char* nA = has_next ? (const char*)g.A + (size_t)nxt.pm * tstep + (size_t)nxt.kb * kstep : cA; const char* nB = has_next ? (const char*)g.Bt + (size_t)nxt.pn * tstep + (size_t)nxt.kb * kstep : cB;
        const int nt = cur.nkt;
        for (int t = 0; t < nt; t += 2) {
            const bool last = (t == nt - 2);
            const char* a1 = cA + (size_t)(t + 1) * kstep;
            const char* a2 = last ? nA : cA + (size_t)(t + 2) * kstep; const char* b2 = last ? nB : cB + (size_t)(t + 2) * kstep;
            const char* a3 = a2 + kstep; const char* b3 = b2 + kstep;
            if (last && has_next) S.a_ready(nxt);
            if constexpr (SP2) {
            PG8_LDB(B0, 0, 0); PG8_LDB(B1, 0, 1); PG8_SCHED; PG8_LDA(At, 0, 0); PG8_STAGE(PG8_SA(1, 1), a1 + hstep, voffA);
            PG8_WAIT_V(8); PG8_WAIT_L(0); PG8_BAR; PG8_MMA(0, 0, At, B0); PG8_MMA(0, 1, At, B1); PG8_BAR; PG8_SCHED;
            PG8_LDA(At, 0, 1); PG8_STAGE(PG8_SB(0, 0), b2, voffB); PG8_STAGE(PG8_SB(0, 1), b2 + hstep, voffB); PG8_STAGE(PG8_SA(0, 0), a2, voffA);
            PG8_WAIT_V(8); PG8_WAIT_L(0); PG8_BAR; PG8_MMA(1, 0, At, B0); PG8_MMA(1, 1, At, B1); PG8_BAR; PG8_SCHED;
            PG8_LDB(B0, 1, 0); PG8_LDB(B1, 1, 1); PG8_SCHED; PG8_LDA(At, 1, 0); PG8_STAGE(PG8_SA(0, 1), a2 + hstep, voffA);
            PG8_WAIT_V(8); PG8_WAIT_L(0); PG8_BAR; PG8_MMA(0, 0, At, B0); PG8_MMA(0, 1, At, B1); PG8_BAR; PG8_SCHED;
            PG8_LDA(At, 1, 1); PG8_STAGE(PG8_SB(1, 0), b3, voffB); PG8_STAGE(PG8_SB(1, 1), b3 + hstep, voffB); PG8_STAGE(PG8_SA(1, 0), a3, voffA);
            PG8_WAIT_V(8); PG8_WAIT_L(0); PG8_BAR; PG8_MMA(1, 0, At, B0); PG8_MMA(1, 1, At, B1); PG8_BAR; PG8_SCHED;
            } else {
            PG8_LDB(B0, 0, 0); PG8_SCHED; PG8_LDA(At, 0, 0); PG8_STAGE(PG8_SA(1, 1), a1 + hstep, voffA);
            PG8_WAIT_L(8); PG8_BAR; PG8_WAIT_L(0); PG8_MMA(0, 0, At, B0); PG8_BAR; PG8_SCHED;
            PG8_LDB(B1, 0, 1); PG8_STAGE(PG8_SB(0, 0), b2, voffB);
            PG8_BAR; PG8_WAIT_L(0); PG8_MMA(0, 1, At, B1); PG8_BAR;
            PG8_LDA(At, 0, 1); PG8_STAGE(PG8_SA(0, 0), a2, voffA);
            PG8_BAR; PG8_WAIT_L(0); PG8_MMA(1, 0, At, B0); PG8_BAR; PG8_SCHED;
            PG8_STAGE(PG8_SB(0, 1), b2 + hstep, voffB);
            PG8_WAIT_V(6); PG8_BAR; PG8_MMA(1, 1, At, B1); PG8_BAR;
            PG8_LDB(B0, 1, 0); PG8_SCHED; PG8_LDA(At, 1, 0); PG8_STAGE(PG8_SA(0, 1), a2 + hstep, voffA);
            PG8_WAIT_L(8); PG8_BAR; PG8_WAIT_L(0); PG8_MMA(0, 0, At, B0); PG8_BAR; PG8_SCHED;
            PG8_LDB(B1, 1, 1); PG8_STAGE(PG8_SB(1, 0), b3, voffB);
            PG8_BAR; PG8_WAIT_L(0); PG8_MMA(0, 1, At, B1); PG8_BAR;
            PG8_LDA(At, 1, 1); PG8_STAGE(PG8_SA(1, 0), a3, voffA);
            PG8_BAR; PG8_WAIT_L(0); PG8_MMA(1, 0, At, B0); PG8_BAR; PG8_SCHED;
            PG8_STAGE(PG8_SB(1, 1), b3 + hstep, voffB);
            PG8_WAIT_V(6); PG8_BAR; PG8_MMA(1, 1, At, B1); PG8_BAR;
            }
        }
        if constexpr (ALIGN_EPI) { if (wr == 0) PG8_BAR; }
        if constexpr (!Epi::AFTER_DRAIN) { E(acc, cur, wr, wc, fr, fq); S.done(cur); }
        if (!has_next) break;
#pragma unroll
        for (int a = 0; a < 2; ++a)
#pragma unroll
            for (int b = 0; b < 2; ++b)
#pragma unroll
                for (int m = 0; m < 4; ++m)
#pragma unroll
                    for (int n = 0; n < 2; ++n) acc[a][b][m][n] = (f32x4){0.f, 0.f, 0.f, 0.f};
        cur = nxt; cA = nA; cB = nB; ++ui;
        if constexpr (ALIGN_EPI) { if (wr == 1) PG8_BAR; }
    }
    PG8_WAIT_V(0);
    if constexpr (!ALIGN_EPI) { if (wr == 0) PG8_BAR; }
    PG8_BAR;
    if constexpr (Epi::AFTER_DRAIN) { E.fused(acc, cur, wr, wc, fr, fq, lds, wid, lane); S.done(cur); }
#undef PG8_SA
#undef PG8_SB
#undef PG8_STAGE
#undef PG8_LDA
#undef PG8_LDB
#undef PG8_MMA
#undef PG8_WAIT_V
#undef PG8_WAIT_L
#undef PG8_BAR
#undef PG8_SCHED
}
}
#define LAS __attribute__((address_space(3)))
#define GAS __attribute__((address_space(1)))
typedef unsigned short bf16;
typedef float f32x4 __attribute__((ext_vector_type(4)));
typedef float f32x16 __attribute__((ext_vector_type(16)));
typedef short bf16x8 __attribute__((ext_vector_type(8)));
typedef short s16x4 __attribute__((ext_vector_type(4)));
typedef unsigned u32x4 __attribute__((ext_vector_type(4)));
typedef unsigned u32x2 __attribute__((ext_vector_type(2)));
typedef _Float16 h16x4 __attribute__((ext_vector_type(4)));

constexpr int D = 1024, NB = 8, SEQ = 4096, CTX = 256, TALL = 4352, MLAT = NB * SEQ, MCTX = NB * CTX, MALL = MLAT + MCTX, FF = 2816;
constexpr float RMS_EPS = 1e-6f, LOG2E = 1.4426950408889634f;
constexpr int NTHREADS = 512, NWAVES = 8;
constexpr int LDS_BYTES = 147456;

constexpr size_t MiB = 1u << 20;
constexpr size_t WS_BAR = 0;
constexpr size_t WS_MOD = 1 * MiB;
constexpr size_t WS_ROPE = 3 * MiB;
constexpr size_t WS_S5LAM = 4 * MiB;
constexpr size_t WS_S5B = 4 * MiB + 256 * 1024;
constexpr size_t WS_S5C = 5 * MiB;
constexpr size_t WS_W13A = 8 * MiB, WS_W2A = 19 * MiB, WS_W13B = 25 * MiB, WS_W2B = 36 * MiB, WS_WM = 42 * MiB;
constexpr size_t WS_X = 56 * MiB;
constexpr size_t WS_H = 192 * MiB;
constexpr size_t WS_U = 260 * MiB;
constexpr size_t WS_Y = 447 * MiB;
constexpr size_t WS_E = 515 * MiB;
constexpr size_t ACT_BYTES = (size_t)MALL * D * 2;
constexpr size_t WS_NEED = 600 * MiB;

struct Args { const float* in[37]; float* out; unsigned char* ws; };

struct Frame {
    LAS unsigned char* lds;
    int tid, lane, wave, G, bid;
    LAS unsigned long long* ptab; GAS float* out; GAS unsigned char* ws;
};
__device__ __forceinline__ const float* inp_(const Frame& F, int i) { const unsigned long long v = F.ptab[i]; const unsigned lo = __builtin_amdgcn_readfirstlane((unsigned)v), hi = __builtin_amdgcn_readfirstlane((unsigned)(v >> 32)); return (const float*)(GAS const float*)(((unsigned long long)hi << 32) | lo); }
#define INP(i) inp_(F, (i))

__device__ __forceinline__ unsigned f2bf(float f) { unsigned u = __builtin_bit_cast(unsigned, f); return (u + 0x7fffu + ((u >> 16) & 1u)) >> 16; }
__device__ __forceinline__ unsigned pk2(float lo, float hi) { return pg8::cvt_pk_bf16(lo, hi); }
__device__ __forceinline__ float bf2f(unsigned short b) { return __uint_as_float(((unsigned)b) << 16); }
__device__ __forceinline__ float bflo(unsigned w) { return __uint_as_float(w << 16); }
__device__ __forceinline__ float bfhi(unsigned w) { return __uint_as_float(w & 0xffff0000u); }
__device__ __forceinline__ float wave_sum(float v) {
#pragma unroll
    for (int o = 1; o < 64; o <<= 1) v += __shfl_xor(v, o);
    return v;
}
__device__ __forceinline__ float fexp(float x) { return __builtin_amdgcn_exp2f(x * LOG2E); }
__device__ __forceinline__ float fsigmoid(float x) { return __builtin_amdgcn_rcpf(1.0f + __builtin_amdgcn_exp2f(-LOG2E * x)); }
__device__ __forceinline__ int crow(int r, int hi) { return (r & 3) + 8 * (r >> 2) + 4 * hi; }
#define LBAR() asm volatile("s_waitcnt lgkmcnt(0)\n\ts_barrier" ::: "memory")
#define MFMA32(a, b, c) __builtin_amdgcn_mfma_f32_32x32x16_bf16((a), (b), (c), 0, 0, 0)
#define MFMA16(a, b, c) __builtin_amdgcn_mfma_f32_16x16x32_bf16((a), (b), (c), 0, 0, 0)

__device__ __forceinline__ void cvt_item(const float* W, int K, int N, bf16* WT, int mode, int row_off, LAS float* scr, int item, int lane) {
    const int nblk = N / 32, kb = item / nblk, nb = item % nblk, k0 = 64 * kb, n0 = 32 * nb;
#pragma unroll
    for (int i = 0; i < 8; ++i) { const int kk = 8 * i + (lane >> 3), c4 = 4 * (lane & 7);
        const f32x4 v = *(const f32x4*)(W + (size_t)(k0 + kk) * N + n0 + c4);
        scr[kk * 33 + c4] = v[0]; scr[kk * 33 + c4 + 1] = v[1]; scr[kk * 33 + c4 + 2] = v[2]; scr[kk * 33 + c4 + 3] = v[3]; }
    asm volatile("s_waitcnt lgkmcnt(0)" ::: "memory");
    const int c = lane & 7;
    const int drow0 = (mode == 0) ? (row_off + n0) : ((n0 >> 7) * 256 + (mode - 1) * 128 + (n0 & 127));
#pragma unroll
    for (int j = 0; j < 4; ++j) { const int n = (lane >> 3) + 8 * j; const LAS float* s = scr + (8 * c) * 33 + n;
        u32x4 o; o.x = pk2(s[0 * 33], s[1 * 33]); o.y = pk2(s[2 * 33], s[3 * 33]); o.z = pk2(s[4 * 33], s[5 * 33]); o.w = pk2(s[6 * 33], s[7 * 33]);
        *(u32x4*)(WT + (size_t)(drow0 + n) * K + k0 + 8 * c) = o; }
    asm volatile("s_waitcnt lgkmcnt(0)" ::: "memory");
}
__device__ __forceinline__ void convert_layer(Frame& F, int li) {
    LAS float* scr = (LAS float*)(F.lds + F.wave * 16384);
    const int gw = F.bid * NWAVES + F.wave, NGW = F.G * NWAVES;
    constexpr int I_UP = (D / 64) * (FF / 32), I_DN = (FF / 64) * (D / 32), I_SQ = (D / 64) * (D / 32);
    const int n_mix = (li == 0) ? I_SQ : (li == 3 ? 6 * I_SQ : 4 * I_SQ);
    const int NITEMS = 4 * I_UP + 2 * I_DN + n_mix;
    bf16* w13a = (bf16*)(F.ws + WS_W13A); bf16* w2a = (bf16*)(F.ws + WS_W2A); bf16* w13b = (bf16*)(F.ws + WS_W13B); bf16* w2b = (bf16*)(F.ws + WS_W2B); bf16* wm = (bf16*)(F.ws + WS_WM);
    const size_t offA = (size_t)(li * 2 + 0) * D * FF, offB = (size_t)(li * 2 + 1) * D * FF;
    for (int it = gw; it < NITEMS; it += NGW) {
        int r = it;
        if (r < I_UP) { cvt_item(INP(8) + offA, D, FF, w13a, 1, 0, scr, r, F.lane); continue; } r -= I_UP;
        if (r < I_UP) { cvt_item(INP(9) + offA, D, FF, w13a, 2, 0, scr, r, F.lane); continue; } r -= I_UP;
        if (r < I_DN) { cvt_item(INP(10) + offA, FF, D, w2a, 0, 0, scr, r, F.lane); continue; } r -= I_DN;
        if (r < I_UP) { cvt_item(INP(8) + offB, D, FF, w13b, 1, 0, scr, r, F.lane); continue; } r -= I_UP;
        if (r < I_UP) { cvt_item(INP(9) + offB, D, FF, w13b, 2, 0, scr, r, F.lane); continue; } r -= I_UP;
        if (r < I_DN) { cvt_item(INP(10) + offB, FF, D, w2b, 0, 0, scr, r, F.lane); continue; } r -= I_DN;
        if (li == 0) { cvt_item(INP(19), D, D, wm, 0, 0, scr, r, F.lane); continue; }
        if (li == 1 || li == 2) {
            const float* wqkv = INP(li == 1 ? 21 : 28); const float* wo = INP(li == 1 ? 22 : 29);
            if (r < 3 * I_SQ) { cvt_item(wqkv, D, 3 * D, wm, 0, 0, scr, r, F.lane); continue; } r -= 3 * I_SQ;
            cvt_item(wo, D, D, wm + (size_t)3 * D * D, 0, 0, scr, r, F.lane); continue;
        }
        if (r < 3 * I_SQ) { cvt_item(INP(31), D, 3 * D, wm, 0, 0, scr, r, F.lane); continue; } r -= 3 * I_SQ;
        if (r < I_SQ) { cvt_item(INP(32), D, D, wm + (size_t)3 * D * D, 0, 0, scr, r, F.lane); continue; } r -= I_SQ;
        if (r < I_SQ) { cvt_item(INP(32) + (size_t)D * D, D, D, wm + (size_t)4 * D * D, 0, 0, scr, r, F.lane); continue; } r -= I_SQ;
        cvt_item(INP(36), D, D, wm + (size_t)5 * D * D, 0, 0, scr, r, F.lane);
    }
}

__device__ __forceinline__ void phase_p0(Frame& F) {
    {
        LAS float* sc = (LAS float*)F.lds;
        LAS float* red = (LAS float*)(F.lds + 40960);
        for (int i = F.tid; i < 9 * 1024; i += NTHREADS) { const int bi = i >> 10, k = i & 1023; const float v = (bi < 8) ? INP(1)[bi * 1024 + k] : INP(3)[k]; sc[i] = v * fsigmoid(v); }
        __syncthreads();
        float* MOD = (float*)(F.ws + WS_MOD);
        const int col = F.tid & 31, ks = F.tid >> 5;
        for (int u = F.bid; u < 4 * 288; u += F.G) {
            const int li = u / 288, c0 = (u % 288) * 32;
            const float* W = INP(4) + (size_t)li * D * 9216 + c0 + col;
            float acc[9];
#pragma unroll
            for (int b = 0; b < 9; ++b) acc[b] = 0.f;
#pragma unroll 2
            for (int k4 = 0; k4 < 16; ++k4) {
                const int k = ks * 64 + k4 * 4;
                const float w0 = W[(size_t)(k + 0) * 9216], w1 = W[(size_t)(k + 1) * 9216], w2 = W[(size_t)(k + 2) * 9216], w3 = W[(size_t)(k + 3) * 9216];
#pragma unroll
                for (int b = 0; b < 9; ++b) { const f32x4 s = *(const LAS f32x4*)(sc + b * 1024 + k); acc[b] += s[0] * w0 + s[1] * w1 + s[2] * w2 + s[3] * w3; }
            }
#pragma unroll
            for (int b = 0; b < 9; ++b) red[(ks * 9 + b) * 32 + col] = acc[b];
            __syncthreads();
            if (F.tid < 288) { const int b = F.tid >> 5, cc = F.tid & 31; float s = 0.f;
#pragma unroll
                for (int q = 0; q < 16; ++q) s += red[(q * 9 + b) * 32 + cc];
                MOD[(size_t)(li * 9 + b) * 9216 + c0 + cc] = s + INP(5)[li * 9216 + c0 + cc]; }
            __syncthreads();
        }
    }
    const int gt = F.bid * NTHREADS + F.tid, NGT = F.G * NTHREADS;
    {
        float* rc = (float*)(F.ws + WS_ROPE); float* rs = rc + 4096 * 32;
        for (int i = gt; i < 4096 * 32; i += NGT) { const int t = i >> 5, p = i & 31;
            const float inv = exp2f(-(float)(p & 15) * (13.287712379549449f / 16.0f));
            const float pos = (p < 16) ? (float)(t >> 6) : (float)(t & 63);
            float s, c; sincosf(pos * inv, &s, &c); rc[i] = c; rs[i] = s; }
    }
    {
        float* LAM = (float*)(F.ws + WS_S5LAM); bf16* BM_ = (bf16*)(F.ws + WS_S5B); bf16* CM_ = (bf16*)(F.ws + WS_S5C);
        const float *a_re = INP(11), *a_im = INP(12), *ldt = INP(13), *b_re = INP(14), *b_im = INP(15), *c_re = INP(16), *c_im = INP(17);
        for (int i = gt; i < 2 * 64 * 64; i += NGT) { const int dg = i >> 6;
            const float dt = expf(ldt[dg]); const float ar = a_re[i], ai = a_im[i];
            const float mag = expf(ar * dt); float s, c; sincosf(ai * dt, &s, &c);
            LAM[2 * i] = mag * c; LAM[2 * i + 1] = mag * s; }
        for (int i = gt; i < 2 * 64 * 4 * 64 * 8; i += NGT) {
            const int j = i & 7, ln = (i >> 3) & 63, cb = (i >> 9) & 3, dg = i >> 11;
            const int p = (ln & 31) + 32 * (cb >> 1), n = 8 * (ln >> 5) + j;
            const int ip = dg * 64 + p;
            const float dt = expf(ldt[dg]); const float ar = a_re[ip], ai = a_im[ip];
            const float mag = expf(ar * dt); float s, c; sincosf(ai * dt, &s, &c);
            const float nr = mag * c - 1.0f, ni = mag * s;
            const float den = 1.0f / (ar * ar + ai * ai);
            const float qr = (nr * ar + ni * ai) * den, qi = (ni * ar - nr * ai) * den;
            const float br = b_re[(size_t)ip * 16 + n], bi = b_im[(size_t)ip * 16 + n];
            const float vr = qr * br - qi * bi, vi = qr * bi + qi * br;
            BM_[i] = (bf16)f2bf((cb & 1) ? vi : vr);
        }
        for (int i = gt; i < 2 * 64 * 4 * 64 * 8; i += NGT) {
            const int j = i & 7, ln = (i >> 3) & 63, kc = (i >> 9) & 3, dg = i >> 11;
            const int n = ln & 15, p = 16 * kc + 4 * (ln >> 4) + (j >> 1);
            const size_t ic = ((size_t)dg * 16 + n) * 64 + p;
            CM_[i] = (bf16)f2bf((j & 1) ? -c_im[ic] : c_re[ic]);
        }
    }
    __syncthreads();
    convert_layer(F, 0);
}

__device__ __forceinline__ void norm_phase(Frame& F, int nrows, bool init, const bf16* Y, const float* gpost, float wgt, int mli, int mj, const float* gpre, int nli, int nj, bool fin, int ysplit = 0) {
    const int gw = F.bid * NWAVES + F.wave, NGW = F.G * NWAVES;
    _Float16* X = (_Float16*)(F.ws + WS_X); bf16* H = (bf16*)(F.ws + WS_H); const float* MOD = (const float*)(F.ws + WS_MOD);
    const int lo = 4 * F.lane;
    const int nlat = nrows < MLAT ? nrows : MLAT;
    const int chunk = (nlat + NGW - 1) / NGW;
    const int rbeg = gw * chunk, rend = (rbeg + chunk < nlat) ? rbeg + chunk : nlat;
    int crow = MLAT + gw; bool ctxmode = false;
    f32x4 pg[4], ps1[4], ps0[4], cgp[4], cgr[4];
    int cur_bi = -1;
    u32x2 pxr[2][4], pyr[2][4]; int pf_row = -1;
#pragma unroll
    for (int j = 0; j < 4; ++j) { cgp[j] = Y ? *(const f32x4*)(gpost + lo + 256 * j) : (f32x4){0.f, 0.f, 0.f, 0.f}; cgr[j] = gpre ? *(const f32x4*)(gpre + lo + 256 * j) : (f32x4){0.f, 0.f, 0.f, 0.f}; }
    for (int row0 = rbeg;; row0 += 2) {
        if (!ctxmode && row0 >= rend) ctxmode = true;
        if (ctxmode) { if (crow >= nrows) break; row0 = crow; crow += NGW; }
        const bool has1 = !ctxmode && (row0 + 1 < rend) && (((row0 + 1) >> 12) == (row0 >> 12));
        const int bi = (row0 < MLAT) ? (row0 >> 12) : 8;
        if (bi != cur_bi) {
            cur_bi = bi;
            const float* gate = MOD + (size_t)(mli * 9 + bi) * 9216 + (mj * 3 + 2) * 1024;
            const float* sh = MOD + (size_t)(nli * 9 + bi) * 9216 + (nj * 3 + 0) * 1024;
#pragma unroll
            for (int j = 0; j < 4; ++j) {
                if (Y) pg[j] = *(const f32x4*)(gate + lo + 256 * j) * cgp[j] * wgt;
                if (gpre) { ps1[j] = (*(const f32x4*)(sh + 1024 + lo + 256 * j) + 1.0f) * cgr[j]; ps0[j] = *(const f32x4*)(sh + lo + 256 * j); }
            }
        }
        const int rows[2] = {row0, has1 ? row0 + 1 : row0};
        f32x4 x[2][4], y[2][4];
        const bool regular = !init && !ctxmode && has1 && (Y != nullptr);
        if (regular) {
            u32x2 cx[2][4], cy[2][4];
            if (pf_row == row0) {
#pragma unroll
                for (int q = 0; q < 2; ++q)
#pragma unroll
                    for (int j = 0; j < 4; ++j) { cx[q][j] = pxr[q][j]; cy[q][j] = pyr[q][j]; }
            } else {
#pragma unroll
                for (int q = 0; q < 2; ++q)
#pragma unroll
                    for (int j = 0; j < 4; ++j) { cx[q][j] = *(const u32x2*)(X + (size_t)(row0 + q) * D + lo + 256 * j); cy[q][j] = *(const u32x2*)(Y + (size_t)(row0 + q) * D + lo + 256 * j); }
            }
            const int nr = row0 + 2;
            if (nr + 1 < rend && (((nr + 1) >> 12) == (row0 >> 12))) {
#pragma unroll
                for (int q = 0; q < 2; ++q)
#pragma unroll
                    for (int j = 0; j < 4; ++j) { pxr[q][j] = *(const u32x2*)(X + (size_t)(nr + q) * D + lo + 256 * j); pyr[q][j] = *(const u32x2*)(Y + (size_t)(nr + q) * D + lo + 256 * j); }
                pf_row = nr;
            } else pf_row = -1;
#pragma unroll
            for (int q = 0; q < 2; ++q)
#pragma unroll
                for (int j = 0; j < 4; ++j) {
                    x[q][j] = __builtin_convertvector(__builtin_bit_cast(h16x4, cx[q][j]), f32x4);
                    y[q][j] = (f32x4){bflo(cy[q][j].x), bfhi(cy[q][j].x), bflo(cy[q][j].y), bfhi(cy[q][j].y)};
                }
        } else
#pragma unroll
        for (int q = 0; q < 2; ++q) {
            const int row = rows[q];
            if (init) {
                const float* src = (row < MLAT) ? INP(0) + (size_t)row * D : INP(2) + (size_t)(row - MLAT) * D;
#pragma unroll
                for (int j = 0; j < 4; ++j) x[q][j] = *(const f32x4*)(src + lo + 256 * j);
            } else {
#pragma unroll
                for (int j = 0; j < 4; ++j) x[q][j] = __builtin_convertvector(*(const h16x4*)(X + (size_t)row * D + lo + 256 * j), f32x4);
            }
            if (Y) {
                if (ysplit > 0 && row >= MLAT) {
                    const bf16* yp = (const bf16*)(F.ws + WS_E) + (size_t)(row - MLAT) * D + lo;
#pragma unroll
                    for (int j = 0; j < 4; ++j) y[q][j] = (f32x4){0.f, 0.f, 0.f, 0.f};
                    for (int p0 = 0; p0 < ysplit; p0 += 4) {
                        u32x2 w[4][4];
#pragma unroll
                        for (int pp = 0; pp < 4; ++pp) { const int p = (p0 + pp < ysplit) ? p0 + pp : p0;
#pragma unroll
                            for (int j = 0; j < 4; ++j) w[pp][j] = *(const u32x2*)(yp + (size_t)p * 2048 * D + 256 * j); }
#pragma unroll
                        for (int pp = 0; pp < 4; ++pp) if (p0 + pp < ysplit) {
#pragma unroll
                            for (int j = 0; j < 4; ++j) y[q][j] = y[q][j] + (f32x4){bflo(w[pp][j].x), bfhi(w[pp][j].x), bflo(w[pp][j].y), bfhi(w[pp][j].y)}; }
                    }
                } else {
#pragma unroll
                    for (int j = 0; j < 4; ++j) { const u32x2 w = *(const u32x2*)(Y + (size_t)row * D + lo + 256 * j); y[q][j] = (f32x4){bflo(w.x), bfhi(w.x), bflo(w.y), bfhi(w.y)}; }
                }
            }
        }
        if (Y) {
            float ss[2];
#pragma unroll
            for (int q = 0; q < 2; ++q) { ss[q] = 0.f;
#pragma unroll
                for (int j = 0; j < 4; ++j) ss[q] += y[q][j][0] * y[q][j][0] + y[q][j][1] * y[q][j][1] + y[q][j][2] * y[q][j][2] + y[q][j][3] * y[q][j][3]; }
#pragma unroll
            for (int o = 1; o < 64; o <<= 1) { ss[0] += __shfl_xor(ss[0], o); ss[1] += __shfl_xor(ss[1], o); }
#pragma unroll
            for (int q = 0; q < 2; ++q) {
                const float rstd = rsqrtf(ss[q] * (1.0f / D) + RMS_EPS);
#pragma unroll
                for (int j = 0; j < 4; ++j) x[q][j] = x[q][j] + pg[j] * y[q][j] * rstd;
            }
        }
#pragma unroll
        for (int q = 0; q < 2; ++q) {
            if (q == 1 && !has1) break;
            if (fin) {
#pragma unroll
                for (int j = 0; j < 4; ++j) *(f32x4*)((float*)F.out + (size_t)rows[q] * D + lo + 256 * j) = x[q][j];
            } else {
#pragma unroll
                for (int j = 0; j < 4; ++j) *(h16x4*)(X + (size_t)rows[q] * D + lo + 256 * j) = __builtin_convertvector(x[q][j], h16x4);
            }
        }
        if (gpre) {
            float ss[2];
#pragma unroll
            for (int q = 0; q < 2; ++q) { ss[q] = 0.f;
#pragma unroll
                for (int j = 0; j < 4; ++j) ss[q] += x[q][j][0] * x[q][j][0] + x[q][j][1] * x[q][j][1] + x[q][j][2] * x[q][j][2] + x[q][j][3] * x[q][j][3]; }
#pragma unroll
            for (int o = 1; o < 64; o <<= 1) { ss[0] += __shfl_xor(ss[0], o); ss[1] += __shfl_xor(ss[1], o); }
#pragma unroll
            for (int q = 0; q < 2; ++q) {
                if (q == 1 && !has1) break;
                const float rstd = rsqrtf(ss[q] * (1.0f / D) + RMS_EPS);
#pragma unroll
                for (int j = 0; j < 4; ++j) {
                    const f32x4 h = x[q][j] * rstd * ps1[j] + ps0[j];
                    u32x2 w; w.x = pk2(h[0], h[1]); w.y = pk2(h[2], h[3]);
                    *(u32x2*)(H + (size_t)rows[q] * D + lo + 256 * j) = w; }
            }
        }
        if (!ctxmode && !has1 && row0 + 1 < rend) row0 -= 1;
    }
}

__device__ __forceinline__ float xhalf(float v, int owner) {
    const auto rr = __builtin_amdgcn_permlane32_swap(__float_as_uint(v), __float_as_uint(v), false, false);
    return __uint_as_float(owner ? rr[1] : rr[0]);
}
__device__ __forceinline__ int s5_row(int b, int dir, int jj) {
    if (jj < 256) return MLAT + b * 256 + (dir ? 255 - jj : jj);
    const int t = jj - 256; return b * 4096 + (dir ? 4095 - t : t);
}
template <bool OUTPUT>
__device__ __forceinline__ void s5_pass(Frame& F) {
    const bf16* H = (const bf16*)(F.ws + WS_H);
    const float* LAM = (const float*)(F.ws + WS_S5LAM); const bf16x8* BMv = (const bf16x8*)(F.ws + WS_S5B); const bf16x8* CMv = (const bf16x8*)(F.ws + WS_S5C);
    float* EST = (float*)(F.ws + WS_U + 2 * ACT_BYTES);
    bf16* Y0 = (bf16*)(F.ws + WS_U); bf16* Y1 = (bf16*)(F.ws + WS_U + ACT_BYTES);
    const int lane = F.lane, pc = lane & 31, hi = lane >> 5;
    LAS unsigned* hm = (LAS unsigned*)(F.lds + F.wave * 8704);
    for (int bu = F.bid; bu < 8 * 2 * 17 * 8; bu += F.G) {
        const int g = 8 * (bu & 7) + F.wave; const int sc = (bu >> 3) % 17; const int bd = (bu >> 3) / 17; const int dir = bd & 1, b = bd >> 1;
        const int dg = dir * 64 + g;
        bf16x8 bfr[4], cfr[4];
#pragma unroll
        for (int q = 0; q < 4; ++q) { bfr[q] = BMv[(dg * 4 + q) * 64 + lane]; if (OUTPUT) cfr[q] = CMv[(dg * 4 + q) * 64 + lane]; }
        const float l0r = LAM[(dg * 64 + pc) * 2], l0i = LAM[(dg * 64 + pc) * 2 + 1], l1r = LAM[(dg * 64 + pc + 32) * 2], l1i = LAM[(dg * 64 + pc + 32) * 2 + 1];
        float h0r = 0.f, h0i = 0.f, h1r = 0.f, h1i = 0.f;
        const size_t ebase = (((size_t)(b * 2 + dir) * 17) * 64 + g) * 128;
        if (OUTPUT) {
            float p0r = l0r, p0i = l0i, p1r = l1r, p1i = l1i;
#pragma unroll
            for (int q = 0; q < 8; ++q) { float t = p0r * p0r - p0i * p0i; p0i = 2.f * p0r * p0i; p0r = t; t = p1r * p1r - p1i * p1i; p1i = 2.f * p1r * p1i; p1r = t; }
            for (int c = 0; c < sc; ++c) {
                const float* e = EST + ebase + (size_t)c * 64 * 128;
                const float e0r = e[pc * 2], e0i = e[pc * 2 + 1], e1r = e[(pc + 32) * 2], e1i = e[(pc + 32) * 2 + 1];
                float t = p0r * h0r - p0i * h0i + e0r; h0i = p0r * h0i + p0i * h0r + e0i; h0r = t;
                t = p1r * h1r - p1i * h1i + e1r; h1i = p1r * h1i + p1i * h1r + e1i; h1r = t;
            }
        }
        bf16x8 ua_next = *(const bf16x8*)(H + (size_t)s5_row(b, dir, sc * 256 + pc) * D + g * 16 + 8 * hi);
        for (int sub = 0; sub < 8; ++sub) {
            const int j0 = sc * 256 + sub * 32;
            const bf16x8 ua = ua_next;
            if (sub + 1 < 8) ua_next = *(const bf16x8*)(H + (size_t)s5_row(b, dir, j0 + 32 + pc) * D + g * 16 + 8 * hi);
            f32x16 d0 = {}, d1 = {}, d2 = {}, d3 = {};
            d0 = MFMA32(ua, bfr[0], d0); d1 = MFMA32(ua, bfr[1], d1); d2 = MFMA32(ua, bfr[2], d2); d3 = MFMA32(ua, bfr[3], d3);
#pragma unroll
            for (int run = 0; run < 8; ++run) {
                const int owner = run & 1, rb = 4 * (run >> 1);
#pragma unroll
                for (int i = 0; i < 4; ++i) {
                    const int r = rb + i;
                    float t = l0r * h0r - l0i * h0i + d0[r]; h0i = l0r * h0i + l0i * h0r + d1[r]; h0r = t;
                    t = l1r * h1r - l1i * h1i + d2[r]; h1i = l1r * h1i + l1i * h1r + d3[r]; h1r = t;
                    if (OUTPUT) { if (hi == owner) { const int s = 4 * run + i; hm[s * 68 + pc] = pk2(h0r, h0i); hm[s * 68 + pc + 32] = pk2(h1r, h1i); } }
                }
                h0r = xhalf(h0r, owner); h0i = xhalf(h0i, owner); h1r = xhalf(h1r, owner); h1i = xhalf(h1i, owner);
            }
            if (OUTPUT) {
                __syncthreads();
                bf16* Yd = dir ? Y1 : Y0;
#pragma unroll
                for (int st = 0; st < 2; ++st) {
                    f32x4 acc = {0.f, 0.f, 0.f, 0.f};
                    const int s = 16 * st + (lane & 15);
#pragma unroll
                    for (int kc = 0; kc < 4; ++kc) { const bf16x8 hb = *(const LAS bf16x8*)(hm + s * 68 + 16 * kc + 4 * (lane >> 4)); acc = MFMA16(cfr[kc], hb, acc); }
                    u32x2 w; w.x = pk2(acc[0], acc[1]); w.y = pk2(acc[2], acc[3]);
                    *(u32x2*)(Yd + (size_t)s5_row(b, dir, j0 + s) * D + g * 16 + 4 * (lane >> 4)) = w;
                }
                __syncthreads();
            }
        }
        if (!OUTPUT) {
            if (hi == 0) { float* e = EST + ebase + (size_t)sc * 64 * 128; e[pc * 2] = h0r; e[pc * 2 + 1] = h0i; e[(pc + 32) * 2] = h1r; e[(pc + 32) * 2 + 1] = h1i; }
        }
    }
}
__device__ __forceinline__ void s5_z_phase(Frame& F) {
    bf16* H = (bf16*)(F.ws + WS_H); const bf16* Y0 = (const bf16*)(F.ws + WS_U); const bf16* Y1 = (const bf16*)(F.ws + WS_U + ACT_BYTES);
    const float* dsk = INP(18);
    const size_t n8 = (size_t)MALL * D / 8;
    for (size_t i = (size_t)F.bid * NTHREADS + F.tid; i < n8; i += (size_t)F.G * NTHREADS) {
        const u32x4 h = *(const u32x4*)(H + i * 8), a = *(const u32x4*)(Y0 + i * 8), c = *(const u32x4*)(Y1 + i * 8);
        const int col = (int)((i * 8) & 1023);
        const f32x4 dA = *(const f32x4*)(dsk + col), dB = *(const f32x4*)(dsk + col + 4);
        const unsigned hh[4] = {h.x, h.y, h.z, h.w}, aa[4] = {a.x, a.y, a.z, a.w}, cc[4] = {c.x, c.y, c.z, c.w};
        unsigned o[4];
#pragma unroll
        for (int j = 0; j < 4; ++j) {
            const float dl = (j < 2) ? dA[2 * j] : dB[2 * j - 4], dh = (j < 2) ? dA[2 * j + 1] : dB[2 * j - 3];
            const float yl = dl * bflo(hh[j]) + bflo(aa[j]) + bflo(cc[j]), yh = dh * bfhi(hh[j]) + bfhi(aa[j]) + bfhi(cc[j]);
            const float zl = yl * fsigmoid(1.5957691216057308f * (yl + 0.044715f * yl * yl * yl)), zh = yh * fsigmoid(1.5957691216057308f * (yh + 0.044715f * yh * yh * yh));
            o[j] = pk2(zl, zh);
        }
        *(u32x4*)(H + i * 8) = (u32x4){o[0], o[1], o[2], o[3]};
    }
}

template <int NDB>
__device__ __forceinline__ void flash_pv(const LAS unsigned char* vs, int r32, int hi, const bf16x8 (&pw)[4], f32x16 (&o)[NDB]) {
    const LAS unsigned char* vrow = vs + r32 * 144 + hi * 16;
#pragma unroll
    for (int d2 = 0; d2 < NDB; d2 += 2) {
        bf16x8 vf[2][4];
#pragma unroll
        for (int db = 0; db < 2; ++db)
#pragma unroll
            for (int q = 0; q < 4; ++q) vf[db][q] = *(const LAS bf16x8*)(vrow + (d2 + db) * 32 * 144 + q * 32);
        __builtin_amdgcn_sched_barrier(0);
#pragma unroll
        for (int q = 0; q < 4; ++q)
#pragma unroll
            for (int db = 0; db < 2; ++db) o[d2 + db] = MFMA32(vf[db][q], pw[q], o[d2 + db]);
        __builtin_amdgcn_sched_barrier(0);
    }
}
template <int DV, bool NA>
__device__ __forceinline__ void flash_pass(Frame& F, const bf16* Qw  , const bf16* Kb, const bf16* Vtb, int ta1, int tb0, int tb1,
                                           int rq, int qc, f32x16 (&o)[DV / 32]) {
    constexpr bool na = NA;
    constexpr int NDB = DV / 32, KS_B = 64 * 72 * 2, VS_B = DV * 72 * 2, VOFF = 2 * KS_B, BOFF = VOFF + 3 * VS_B;
    constexpr int NVL = DV / 64;
    const int tid = F.tid, lane = F.lane, r32 = lane & 31, hi = lane >> 5;
    const bool grpB = (F.wave & 1);
    const LAS float* bias = (const LAS float*)(F.lds + BOFF);
    bf16x8 qr[4];
#pragma unroll
    for (int d0 = 0; d0 < 4; ++d0) qr[d0] = *(const bf16x8*)(Qw + (size_t)r32 * 64 + d0 * 16 + hi * 8);
#pragma unroll
    for (int db = 0; db < NDB; ++db) o[db] = (f32x16){};
    float mrun = -3.0e38f, lrun = 0.f;
    const int nt = ta1 + (tb1 - tb0);
    const int krow = tid >> 3, kch = tid & 7;
    u32x4 kregA, kregB; u32x4 vregA[NVL], vregB[NVL];
    bf16x8 pw[4]; bool havePV = false; int pvb = 0;
#define FL_VDST(vbuf, idx) (F.lds + VOFF + (vbuf) * VS_B + ((idx) >> 3) * 144 + (((idx) & 7) >> 1) * 32 + ((idx) & 1) * 8)
#define FL_TILE(i) (((i) < ta1) ? (i) : tb0 + ((i) - ta1))
#define FL_LOAD(KR, VR, i) do { const int tl_ = FL_TILE(i); KR = *(const u32x4*)(Kb + ((size_t)tl_ * 64 + krow) * 64 + kch * 8); \
        _Pragma("unroll") for (int i_ = 0; i_ < NVL; ++i_) { const int idx = tid + 512 * i_; VR[i_] = *(const u32x4*)(Vtb + (size_t)(idx >> 3) * TALL + tl_ * 64 + (idx & 7) * 8); } } while (0)
#define FL_STORE(KR, VR, kbuf, vbuf) do { *(LAS u32x4*)(F.lds + (kbuf) * KS_B + krow * 144 + kch * 16) = KR; \
        _Pragma("unroll") for (int i_ = 0; i_ < NVL; ++i_) { const int idx = tid + 512 * i_; LAS unsigned char* p = FL_VDST(vbuf, idx); *(LAS u32x2*)p = (u32x2){VR[i_].x, VR[i_].y}; *(LAS u32x2*)(p + 16) = (u32x2){VR[i_].z, VR[i_].w}; } } while (0)
    FL_LOAD(kregA, vregA, 0); FL_STORE(kregA, vregA, 0, 0);
    if (1 < nt) FL_LOAD(kregA, vregA, 1);
    if (2 < nt) FL_LOAD(kregB, vregB, 2);
    __syncthreads();
    int vb = 0;
    auto step = [&](const int it, u32x4& kregX, u32x4 (&vregX)[NVL]) {
        const int buf = it & 1;
        const int tile = FL_TILE(it);
        const bool more = (it + 1 < nt);
        if (havePV) { flash_pv<NDB>(F.lds + VOFF + pvb * VS_B, r32, hi, pw, o); havePV = false; }
        bool active = true; int kr = 0;
        if (na && tile >= 4) { kr = tile - 4; int r0 = rq - 4; r0 = r0 < 0 ? 0 : (r0 > 56 ? 56 : r0); active = (kr >= r0) && (kr < r0 + 8); }
        if (active) {
            const LAS unsigned char* ks = F.lds + buf * KS_B;
            f32x16 p0 = {}, p1 = {};
            {
                bf16x8 kf[8];
#pragma unroll
                for (int d0 = 0; d0 < 4; ++d0) { kf[2 * d0] = *(const LAS bf16x8*)(ks + r32 * 144 + d0 * 32 + hi * 16); kf[2 * d0 + 1] = *(const LAS bf16x8*)(ks + (32 + r32) * 144 + d0 * 32 + hi * 16); }
                __builtin_amdgcn_sched_barrier(0);
#pragma unroll
                for (int d0 = 0; d0 < 4; ++d0) { p0 = MFMA32(kf[2 * d0], qr[d0], p0); p1 = MFMA32(kf[2 * d0 + 1], qr[d0], p1); }
            }
            if (na && tile >= 4) {
                int c0 = qc - 8; c0 = c0 < 0 ? 0 : (c0 > 48 ? 48 : c0);
                const int brow = (kr - rq + 7) * 31 + 15 - qc;
#pragma unroll
                for (int r = 0; r < 16; ++r) {
                    const int kc0 = crow(r, hi), kc1 = 32 + kc0;
                    const bool v0 = (kc0 >= c0) && (kc0 < c0 + 16), v1 = (kc1 >= c0) && (kc1 < c0 + 16);
                    p0[r] = v0 ? p0[r] + bias[brow + kc0] : -1.0e30f;
                    p1[r] = v1 ? p1[r] + bias[brow + kc1] : -1.0e30f;
                }
            }
            float mx;
            { float t[16];
#pragma unroll
              for (int r = 0; r < 16; ++r) t[r] = fmaxf(p0[r], p1[r]);
#pragma unroll
              for (int w_ = 8; w_ >= 1; w_ >>= 1)
#pragma unroll
                  for (int r = 0; r < w_; ++r) t[r] = fmaxf(t[r], t[r + w_]);
              mx = t[0]; }
            mx = fmaxf(mx, __shfl_xor(mx, 32));
            if (__any(mx > mrun + 8.0f)) {
                const float mnew = fmaxf(mrun, mx);
                const float alpha = __builtin_amdgcn_exp2f(mrun - mnew);
                mrun = mnew; lrun *= alpha;
#pragma unroll
                for (int db = 0; db < NDB; ++db)
#pragma unroll
                    for (int r = 0; r < 16; ++r) o[db][r] *= alpha;
            }
            { float t[16];
#pragma unroll
              for (int r = 0; r < 16; ++r) { p0[r] = __builtin_amdgcn_exp2f(p0[r] - mrun); p1[r] = __builtin_amdgcn_exp2f(p1[r] - mrun); t[r] = p0[r] + p1[r]; }
#pragma unroll
              for (int w_ = 8; w_ >= 1; w_ >>= 1)
#pragma unroll
                  for (int r = 0; r < w_; ++r) t[r] += t[r + w_];
              lrun += t[0]; }
#pragma unroll
            for (int q = 0; q < 4; ++q) {
                u32x4 w;
                if (q < 2) { w.x = pk2(p0[8 * q + 0], p0[8 * q + 1]); w.y = pk2(p0[8 * q + 2], p0[8 * q + 3]); w.z = pk2(p0[8 * q + 4], p0[8 * q + 5]); w.w = pk2(p0[8 * q + 6], p0[8 * q + 7]); }
                else { const int qq = q - 2; w.x = pk2(p1[8 * qq + 0], p1[8 * qq + 1]); w.y = pk2(p1[8 * qq + 2], p1[8 * qq + 3]); w.z = pk2(p1[8 * qq + 4], p1[8 * qq + 5]); w.w = pk2(p1[8 * qq + 6], p1[8 * qq + 7]); }
                pw[q] = __builtin_bit_cast(bf16x8, w);
            }
            if (grpB) { havePV = true; pvb = vb; }
            else flash_pv<NDB>(F.lds + VOFF + vb * VS_B, r32, hi, pw, o);
        }
        const int vnext = (vb == 2) ? 0 : vb + 1;
        if (more) {
            FL_STORE(kregX, vregX, buf ^ 1, vnext);
            if (it + 3 < nt) FL_LOAD(kregX, vregX, it + 3);
        }
        vb = vnext;
        __syncthreads();
    };
    for (int it = 0; it < nt; it += 2) {
        step(it, kregA, vregA);
        if (it + 1 < nt) step(it + 1, kregB, vregB);
    }
    if (havePV) flash_pv<NDB>(F.lds + VOFF + pvb * VS_B, r32, hi, pw, o);
    __syncthreads();
#undef FL_VDST
#undef FL_TILE
#undef FL_LOAD
#undef FL_STORE
    lrun += __shfl_xor(lrun, 32);
    const float rl = 1.0f / lrun;
#pragma unroll
    for (int db = 0; db < NDB; ++db)
#pragma unroll
        for (int r = 0; r < 16; ++r) o[db][r] *= rl;
}

__device__ __forceinline__ void att_da_phase(Frame& F) {
    const bf16* Q = (const bf16*)(F.ws + WS_U); const bf16* K = (const bf16*)(F.ws + WS_U + ACT_BYTES); const bf16* Vt = (const bf16*)(F.ws + WS_U + 2 * ACT_BYTES);
    bf16* OA = (bf16*)(F.ws + WS_H);
    float* stash = (float*)(F.ws + WS_E) + (size_t)F.bid * (8 * 64 * 64) + F.wave * (64 * 64);
    float s1 = 0.f, s2 = 0.f;
    for (int i = 0; i < 64; ++i) { s1 += INP(23)[i] * INP(24)[i]; s2 += INP(25)[i] * INP(26)[i]; }
    const float lam_init = 0.8f - 0.6f * expf(-0.3f * 1.0f);
    const float lam = expf(s1) - expf(s2) + lam_init;
    const int lane = F.lane, r32 = lane & 31, hi = lane >> 5;
    const int vcu = (F.G % 8 == 0) ? (F.bid % 8) * (F.G / 8) + F.bid / 8 : F.bid;
    for (int u = vcu; u < 8 * 8 * 17; u += F.G) {
        int b, h, qb;
        if (u < 1024) { b = u >> 7; h = (u >> 4) & 7; qb = 1 + (u & 15); } else { const int v = u - 1024; b = v >> 3; h = v & 7; qb = 0; }
        const int s0 = 256 * qb + 32 * F.wave;
        const int nta = qb ? 68 : 4;
        f32x16 o[4];
#pragma unroll 1
        for (int m = 0; m < 2; ++m) {
            const int hm = 2 * h + m;
            flash_pass<128, false>(F, Q + ((size_t)(b * 16 + hm) * TALL + s0) * 64, K + (size_t)(b * 16 + hm) * TALL * 64, Vt + (size_t)(b * 8 + h) * 128 * TALL, nta, 0, 0, 0, 0, o);
            if (m == 0) {
                GAS float* sp = (GAS float*)(stash + lane); asm volatile("" : "+v"(sp));
#pragma unroll
                for (int db = 0; db < 4; ++db)
#pragma unroll
                    for (int r = 0; r < 16; ++r) sp[(db * 16 + r) * 64] = o[db][r];
            }
        }
        float ss = 0.f;
        {
            const GAS float* sp = (const GAS float*)(stash + lane); asm volatile("" : "+v"(sp));
#pragma unroll
            for (int db = 0; db < 4; ++db) {
#pragma unroll
                for (int r = 0; r < 16; ++r) { const float a = sp[(db * 16 + r) * 64] - lam * o[db][r]; o[db][r] = a; ss += a * a; }
                asm volatile("" ::: "memory");
            }
        }
        ss += __shfl_xor(ss, 32);
        const float rstd = rsqrtf(ss * (1.0f / 128.0f) + RMS_EPS) * (1.0f - lam_init);
        const int s = s0 + r32;
        const size_t row = qb ? (size_t)b * 4096 + (s - 256) : (size_t)MLAT + b * 256 + s;
        GAS bf16* op = (GAS bf16*)(OA + row * D + h * 128 + 4 * hi); asm volatile("" : "+v"(op));
        const GAS float* gp = (const GAS float*)(INP(27) + 4 * hi); asm volatile("" : "+v"(gp));
#pragma unroll
        for (int db = 0; db < 4; ++db)
#pragma unroll
            for (int rg = 0; rg < 4; ++rg) {
                const int d = 32 * db + 8 * rg;
                const f32x4 g = *(const GAS f32x4*)(gp + d);
                u32x2 w; w.x = pk2(o[db][4 * rg] * rstd * g[0], o[db][4 * rg + 1] * rstd * g[1]); w.y = pk2(o[db][4 * rg + 2] * rstd * g[2], o[db][4 * rg + 3] * rstd * g[3]);
                *(GAS u32x2*)(op + d) = w;
            }
    }
}
__device__ __forceinline__ void att_na_phase(Frame& F) {
    const bf16* Q = (const bf16*)(F.ws + WS_U); const bf16* K = (const bf16*)(F.ws + WS_U + ACT_BYTES); const bf16* Vt = (const bf16*)(F.ws + WS_U + 2 * ACT_BYTES);
    bf16* OA = (bf16*)(F.ws + WS_H);
    constexpr int BOFF = 2 * 64 * 72 * 2 + 3 * 64 * 72 * 2;
    LAS float* bias = (LAS float*)(F.lds + BOFF);
    const int lane = F.lane, r32 = lane & 31, hi = lane >> 5;
    const int vcu = (F.G % 8 == 0) ? (F.bid % 8) * (F.G / 8) + F.bid / 8 : F.bid;
    for (int u = vcu; u < 8 * 16 * 17; u += F.G) {
        int b, h, R4; bool lat;
        if (u < 2048) { b = u >> 8; h = (u >> 4) & 15; R4 = u & 15; lat = true; } else { const int v = u - 2048; b = v >> 4; h = v & 15; R4 = 0; lat = false; }
        if (lat) { for (int i = F.tid; i < 15 * 31; i += NTHREADS) bias[i] = INP(30)[h * 465 + i] * LOG2E; }
        const int s0 = (lat ? 256 + 256 * R4 : 0) + 32 * F.wave;
        int lo = 4 * R4 - 4; lo = lo < 0 ? 0 : (lo > 56 ? 56 : lo);
        int hh = 4 * R4 + 3 - 4; hh = hh < 0 ? 0 : (hh > 56 ? 56 : hh); hh += 8;
        f32x16 o[2];
        if (lat) flash_pass<64, true>(F, Q + ((size_t)(b * 16 + h) * TALL + s0) * 64, K + (size_t)(b * 16 + h) * TALL * 64, Vt + (size_t)(b * 16 + h) * 64 * TALL, 4, 4 + lo, 4 + hh, 4 * R4 + (F.wave >> 1), 32 * (F.wave & 1) + r32, o);
        else flash_pass<64, false>(F, Q + ((size_t)(b * 16 + h) * TALL + s0) * 64, K + (size_t)(b * 16 + h) * TALL * 64, Vt + (size_t)(b * 16 + h) * 64 * TALL, 4, 0, 0, 0, 0, o);
        const int s = s0 + r32;
        const size_t row = lat ? (size_t)b * 4096 + (s - 256) : (size_t)MLAT + b * 256 + s;
        GAS bf16* op = (GAS bf16*)(OA + row * D + h * 64 + 4 * hi); asm volatile("" : "+v"(op));
#pragma unroll
        for (int db = 0; db < 2; ++db)
#pragma unroll
            for (int rg = 0; rg < 4; ++rg) {
                const int d = 32 * db + 8 * rg;
                u32x2 w; w.x = pk2(o[db][4 * rg], o[db][4 * rg + 1]); w.y = pk2(o[db][4 * rg + 2], o[db][4 * rg + 3]);
                *(GAS u32x2*)(op + d) = w;
            }
    }
}

__device__ __forceinline__ bf16* hg_o1_row(Frame& F, int row) {
    return (bf16*)(F.ws + WS_U + 4 * ACT_BYTES) + (size_t)row * D;
}
__device__ __forceinline__ void gla_phase(Frame& F) {
    const bf16* Qb = (const bf16*)(F.ws + WS_U); const bf16* Ib = (const bf16*)(F.ws + WS_U + ACT_BYTES);
    const bf16* Z0 = (const bf16*)F.out; const bf16* Z1 = (const bf16*)(F.ws + WS_U + 3 * ACT_BYTES);
    bf16* O0 = (bf16*)(F.ws + WS_H);
    constexpr int QD = 0, KI = 17408, KDT = 34816, VT = 53248, ST = 62464, ATT = 79872, GL = 89088, TOT = 89600;
    constexpr int ZS = 91648, QS = ZS + 17408, VS2 = QS + 17408;
    const int tid = F.tid, lane = F.lane, w = F.wave, r32 = lane & 31, hi = lane >> 5;
    const int kcol = tid & 127, tq = tid >> 7, vcol = tid & 63, tv = tid >> 6;
    for (int u = F.bid; u < 256; u += F.G) {
        const int b = u >> 5, h = (u >> 2) & 7, dir = (u >> 1) & 1, vh = u & 1;
        const bf16* Zd = dir ? Z1 : Z0;
        float lbk;
        { const int c = h * 128 + kcol; const float a0 = INP(34)[c], a1 = INP(34)[1024 + c], a2 = INP(34)[2048 + c], a3 = INP(34)[3072 + c];
          const float mx = fmaxf(fmaxf(a0, a1), fmaxf(a2, a3)); const float e0 = expf(a0 - mx), e1 = expf(a1 - mx), e2 = expf(a2 - mx), e3 = expf(a3 - mx);
          lbk = (e1 + e2 + e3) / (e0 + e1 + e2 + e3); }
        const float omlb = 1.0f - lbk;
        f32x16 S = {};
        for (int i = tid; i < 17408 / 4; i += NTHREADS) ((LAS unsigned*)(F.lds + ST))[i] = 0u;
        const int kb = w >> 1, vb = w & 1;
        u32x4 zreg[2], qreg[2], vreg;
        const int sj0 = tid >> 4, sc0 = (tid & 15) * 8;
        const int vj = tid >> 3, vc = (tid & 7) * 8;
#define GLA_ROW(c, j) ((c) < 4 ? (MLAT + b * 256 + (dir ? 255 - (64 * (c) + (j)) : 64 * (c) + (j))) : (b * 4096 + (dir ? 4095 - (64 * ((c) - 4) + (j)) : 64 * ((c) - 4) + (j))))
#define GLA_LOAD(c) do { _Pragma("unroll") for (int i = 0; i < 2; ++i) { const size_t ro = (size_t)GLA_ROW(c, sj0 + 32 * i) * D + h * 128 + sc0; zreg[i] = *(const u32x4*)(Zd + ro); qreg[i] = *(const u32x4*)(Qb + ro); } \
        vreg = *(const u32x4*)(Ib + (size_t)GLA_ROW(c, vj) * D + h * 128 + vh * 64 + vc); } while (0)
#define GLA_PARK() do { _Pragma("unroll") for (int i = 0; i < 2; ++i) { *(LAS u32x4*)(F.lds + ZS + (sj0 + 32 * i) * 272 + sc0 * 2) = zreg[i]; *(LAS u32x4*)(F.lds + QS + (sj0 + 32 * i) * 272 + sc0 * 2) = qreg[i]; } \
        *(LAS u32x4*)(F.lds + VS2 + vj * 144 + vc * 2) = vreg; } while (0)
        GLA_LOAD(0); GLA_PARK(); GLA_LOAD(1);
        __syncthreads();
        for (int c = 0; c < 68; ++c) {
            float g[16], kk[16], run = 0.f;
#pragma unroll
            for (int i = 0; i < 16; ++i) { const float sg = fsigmoid(bf2f(((const LAS bf16*)(F.lds + ZS))[(16 * tq + i) * 136 + kcol])); const float f = lbk + omlb * sg; run += __logf(f); g[i] = run; kk[i] = omlb * (1.0f - sg); }
            ((LAS float*)(F.lds + TOT))[tq * 128 + kcol] = run;
            __syncthreads();
            float pre = 0.f, gl = 0.f;
#pragma unroll
            for (int q = 0; q < 4; ++q) { const float t = ((LAS float*)(F.lds + TOT))[q * 128 + kcol]; gl += t; if (q < tq) pre += t; }
            const float egl = fexp(gl);
            unsigned kdp[8];
#pragma unroll
            for (int i = 0; i < 16; i += 2) {
                const float g0 = g[i] + pre, g1 = g[i + 1] + pre;
                const float e0 = fexp(g0), e1 = fexp(g1);
                const float ie0 = __builtin_amdgcn_rcpf(e0), ie1 = __builtin_amdgcn_rcpf(e1);
                const int j0 = 16 * tq + i;
                const float q0 = bf2f(((const LAS bf16*)(F.lds + QS))[j0 * 136 + kcol]), q1 = bf2f(((const LAS bf16*)(F.lds + QS))[(j0 + 1) * 136 + kcol]);
                ((LAS bf16*)(F.lds + QD))[j0 * 136 + kcol] = (bf16)f2bf(q0 * e0); ((LAS bf16*)(F.lds + QD))[(j0 + 1) * 136 + kcol] = (bf16)f2bf(q1 * e1);
                ((LAS bf16*)(F.lds + KI))[j0 * 136 + kcol] = (bf16)f2bf(kk[i] * ie0); ((LAS bf16*)(F.lds + KI))[(j0 + 1) * 136 + kcol] = (bf16)f2bf(kk[i + 1] * ie1);
                kdp[i >> 1] = pk2(kk[i] * egl * ie0, kk[i + 1] * egl * ie1);
            }
            { LAS u32x4* p = (LAS u32x4*)(F.lds + KDT + kcol * 144 + tq * 32); p[0] = (u32x4){kdp[0], kdp[1], kdp[2], kdp[3]}; p[1] = (u32x4){kdp[4], kdp[5], kdp[6], kdp[7]}; }
            if (tq == 0) ((LAS float*)(F.lds + GL))[kcol] = egl;
            { unsigned short vr[8];
#pragma unroll
              for (int i = 0; i < 8; ++i) vr[i] = ((const LAS bf16*)(F.lds + VS2))[(8 * tv + i) * 72 + vcol];
              LAS u32x4* p = (LAS u32x4*)(F.lds + VT + vcol * 144 + tv * 16);
              p[0] = (u32x4){(unsigned)vr[0] | ((unsigned)vr[1] << 16), (unsigned)vr[2] | ((unsigned)vr[3] << 16), (unsigned)vr[4] | ((unsigned)vr[5] << 16), (unsigned)vr[6] | ((unsigned)vr[7] << 16)}; }
            __syncthreads();
            f32x16 oacc = {};
            const int tb = (w - 4) >> 1, ovb = (w - 4) & 1;
            if (c >= 4) {
                if (w < 3) {
                    const int atb = (w >= 1), asb = (w == 2);
                    f32x16 a = {};
#pragma unroll
                    for (int q = 0; q < 8; ++q) {
                        const bf16x8 fa = *(const LAS bf16x8*)(F.lds + QD + (32 * atb + r32) * 272 + q * 32 + hi * 16);
                        const bf16x8 fb = *(const LAS bf16x8*)(F.lds + KI + (32 * asb + r32) * 272 + q * 32 + hi * 16);
                        a = MFMA32(fa, fb, a);
                    }
                    const int sg = 32 * asb + r32;
#pragma unroll
                    for (int r = 0; r < 16; ++r) { const int t = 32 * atb + crow(r, hi); ((LAS bf16*)(F.lds + ATT))[t * 72 + sg] = (bf16)f2bf(sg <= t ? a[r] : 0.f); }
                } else if (w >= 4) {
#pragma unroll
                    for (int q = 0; q < 8; ++q) {
                        const bf16x8 fa = *(const LAS bf16x8*)(F.lds + QD + (32 * tb + r32) * 272 + q * 32 + hi * 16);
                        const bf16x8 fb = *(const LAS bf16x8*)(F.lds + ST + (32 * ovb + r32) * 272 + q * 32 + hi * 16);
                        oacc = MFMA32(fa, fb, oacc);
                    }
                }
            }
            __syncthreads();
            if (c >= 4 && w >= 4) {
                const int nss = tb ? 4 : 2;
                for (int q = 0; q < nss; ++q) {
                    const bf16x8 fa = *(const LAS bf16x8*)(F.lds + ATT + (32 * tb + r32) * 144 + q * 32 + hi * 16);
                    const bf16x8 fb = *(const LAS bf16x8*)(F.lds + VT + (32 * ovb + r32) * 144 + q * 32 + hi * 16);
                    oacc = MFMA32(fa, fb, oacc);
                }
#pragma unroll
                for (int r = 0; r < 16; ++r) { const int row = GLA_ROW(c, 32 * tb + crow(r, hi));
                    bf16* dst = (dir ? hg_o1_row(F, row) : O0 + (size_t)row * D) + h * 128 + vh * 64 + 32 * ovb + r32;
                    *dst = (bf16)f2bf(oacc[r]); }
            }
            {
                f32x16 ds = {};
#pragma unroll
                for (int q = 0; q < 4; ++q) {
                    const bf16x8 fa = *(const LAS bf16x8*)(F.lds + KDT + (32 * kb + r32) * 144 + q * 32 + hi * 16);
                    const bf16x8 fb = *(const LAS bf16x8*)(F.lds + VT + (32 * vb + r32) * 144 + q * 32 + hi * 16);
                    ds = MFMA32(fa, fb, ds);
                }
#pragma unroll
                for (int r = 0; r < 16; ++r) S[r] = ((LAS float*)(F.lds + GL))[32 * kb + crow(r, hi)] * S[r] + ds[r];
#pragma unroll
                for (int rg = 0; rg < 4; ++rg) { u32x2 wv; wv.x = pk2(S[4 * rg], S[4 * rg + 1]); wv.y = pk2(S[4 * rg + 2], S[4 * rg + 3]);
                    *(LAS u32x2*)(F.lds + ST + (32 * vb + r32) * 272 + (32 * kb + 8 * rg + 4 * hi) * 2) = wv; }
            }
            if (c + 1 < 68) { GLA_PARK(); if (c + 2 < 68) GLA_LOAD(c + 2); }
            __syncthreads();
        }
#undef GLA_LOAD
#undef GLA_PARK
#undef GLA_ROW
    }
}
__device__ __forceinline__ void hg_readout_phase(Frame& F) {
    const bf16* O0 = (const bf16*)(F.ws + WS_H); const bf16* Gt = (const bf16*)(F.ws + WS_U + 2 * ACT_BYTES);
    bf16* Hout = (bf16*)(F.ws + WS_H);
    const int gw = F.bid * NWAVES + F.wave, NGW = F.G * NWAVES;
    const int c0 = 16 * F.lane;
    for (int row = gw; row < MLAT; row += NGW) {
        const u32x4 a0 = *(const u32x4*)(O0 + (size_t)row * D + c0), a1 = *(const u32x4*)(O0 + (size_t)row * D + c0 + 8);
        const bf16* o1p = hg_o1_row(F, row) + c0;
        const u32x4 b0 = *(const u32x4*)o1p, b1 = *(const u32x4*)(o1p + 8);
        const u32x4 g0 = *(const u32x4*)(Gt + (size_t)row * D + c0), g1 = *(const u32x4*)(Gt + (size_t)row * D + c0 + 8);
        const unsigned aa[8] = {a0.x, a0.y, a0.z, a0.w, a1.x, a1.y, a1.z, a1.w}, bb[8] = {b0.x, b0.y, b0.z, b0.w, b1.x, b1.y, b1.z, b1.w}, gg[8] = {g0.x, g0.y, g0.z, g0.w, g1.x, g1.y, g1.z, g1.w};
        float v[16]; float ss = 0.f;
#pragma unroll
        for (int j = 0; j < 8; ++j) { v[2 * j] = bflo(aa[j]) + bflo(bb[j]); v[2 * j + 1] = bfhi(aa[j]) + bfhi(bb[j]); ss += v[2 * j] * v[2 * j] + v[2 * j + 1] * v[2 * j + 1]; }
        ss += __shfl_xor(ss, 1); ss += __shfl_xor(ss, 2); ss += __shfl_xor(ss, 4);
        const float rstd = rsqrtf(ss * (1.0f / 128.0f) + RMS_EPS);
        unsigned o[8];
#pragma unroll
        for (int j = 0; j < 8; ++j) {
            const float gl = bflo(gg[j]), gh = bfhi(gg[j]);
            const float n0 = INP(35)[(c0 + 2 * j) & 127], n1 = INP(35)[(c0 + 2 * j + 1) & 127];
            o[j] = pk2(v[2 * j] * rstd * n0 * gl * fsigmoid(gl), v[2 * j + 1] * rstd * n1 * gh * fsigmoid(gh));
        }
        *(u32x4*)(Hout + (size_t)row * D + c0) = (u32x4){o[0], o[1], o[2], o[3]};
        *(u32x4*)(Hout + (size_t)row * D + c0 + 8) = (u32x4){o[4], o[5], o[6], o[7]};
    }
}

#define XB_TMO      128
#define XB_XCNT(j)  (256  + 64 * (j))
#define XB_XSUB(j)  (1280 + 64 * (j))
#define XB_XGEN(j)  (2304 + 64 * (j))
#define XB_TOP      3328
#define XB_TOPGEN   3392
#define XCD_BAR_WORDS 3456
#define XB_SPIN_CAP (1u << 18)

__device__ __forceinline__ unsigned xb_ld(unsigned* p)              { return __hip_atomic_load(p, __ATOMIC_RELAXED, __HIP_MEMORY_SCOPE_AGENT); }
__device__ __forceinline__ unsigned xb_add(unsigned* p, unsigned v) { return __hip_atomic_fetch_add(p, v, __ATOMIC_RELAXED, __HIP_MEMORY_SCOPE_AGENT); }
__device__ __forceinline__ unsigned xb_xcc_id() { return (unsigned)__builtin_amdgcn_s_getreg((3 << 11) | 20) & 0xFu; }
#define XB_SPIN(cond, bar) do { unsigned _sp = 0; while (cond) { __builtin_amdgcn_s_sleep(1); \
    if ((++_sp & 255u) == 0u) { if (xb_ld(&(bar)[XB_TMO])) break; if (_sp > XB_SPIN_CAP) { atomicAdd(&(bar)[XB_TMO], 1u); break; } } } } while (0)

struct XcdBarrier {
    unsigned* bar; unsigned x;
    volatile LAS unsigned* st;
};

__device__ __forceinline__ XcdBarrier xcd_barrier_post(unsigned* bar, volatile LAS unsigned* st) {
    XcdBarrier b; b.bar = bar; b.x = xb_xcc_id(); b.st = st;
    if (threadIdx.x == 0) (void)xb_add(&bar[XB_XCNT(b.x)], 1u);
    return b;
}
__device__ __forceinline__ void xcd_barrier_complete(unsigned* bar, unsigned x, unsigned& nloc, unsigned& nx) {
    const unsigned G = gridDim.x * gridDim.y * gridDim.z;
    unsigned sum, cnt, mine, sp = 0u;
    for (;;) {
        sum = 0u; cnt = 0u; mine = 0u;
#pragma unroll
        for (unsigned j = 0; j < 16; ++j) { const unsigned c = xb_ld(&bar[XB_XCNT(j)]); sum += c; cnt += (c > 0u) ? 1u : 0u; mine = (j == x) ? c : mine; }
        if (sum == G) break;
        __builtin_amdgcn_s_sleep(1);
        if ((++sp & 255u) == 0u) { if (xb_ld(&bar[XB_TMO])) break; if (sp > XB_SPIN_CAP) { atomicAdd(&bar[XB_TMO], 1u); break; } }
    }
    nloc = mine > 0u ? mine : 1u; nx = cnt > 0u ? cnt : 1u;
}

__device__ __forceinline__ void xcd_barrier(const XcdBarrier& b) {
    asm volatile("s_waitcnt vmcnt(0)" ::: "memory");
    __syncthreads();
    if (threadIdx.x == 0) {
        unsigned* bar = b.bar;
        __builtin_amdgcn_s_waitcnt(0);
        unsigned nloc = b.st[0], nx = b.st[1];
        if (nloc == 0u) { xcd_barrier_complete(bar, b.x, nloc, nx); b.st[0] = nloc; b.st[1] = nx; }
        const unsigned old = xb_add(&bar[XB_XSUB(b.x)], 1u);
        const unsigned gen = old / nloc;
        if (old + 1u == (gen + 1u) * nloc) {
            __builtin_amdgcn_fence(__ATOMIC_RELEASE, "agent");
            asm volatile("s_waitcnt vmcnt(0)" ::: "memory");
            const unsigned og = xb_add(&bar[XB_TOP], 1u);
            const unsigned tg = og / nx;
            if (og + 1u == (tg + 1u) * nx) xb_add(&bar[XB_TOPGEN], 1u);
            else XB_SPIN(xb_ld(&bar[XB_TOPGEN]) == tg, bar);
            __builtin_amdgcn_fence(__ATOMIC_ACQUIRE, "agent");
            xb_add(&bar[XB_XGEN(b.x)], 1u);
            asm volatile("s_waitcnt vmcnt(0)" ::: "memory");
        } else {
            XB_SPIN(xb_ld(&bar[XB_XGEN(b.x)]) == gen, bar);
            __builtin_amdgcn_fence(__ATOMIC_ACQUIRE, "agent");
            asm volatile("s_waitcnt vmcnt(0)" ::: "memory");
        }
    }
    __syncthreads();
}

#ifndef PHASE_MASK
#define PHASE_MASK 0xffff
#endif
#define PH_ON(op) (((PHASE_MASK) >> (op)) & 1)
enum { OP_NOP = 0, OP_SWIGLU, OP_BF16, OP_NORM, OP_S5A, OP_S5B, OP_S5Z, OP_GLU, OP_QKV_DA, OP_QKV_NA, OP_ATT_DA, OP_ATT_NA, OP_GLA, OP_READOUT };
#define ST(op, sub) ((op) | ((sub) << 4))
#define NOSYNC 256
__device__ const int PROGRAM[4][12] = {
    {ST(OP_SWIGLU, 0), ST(OP_BF16, 0), ST(OP_NORM, 0), ST(OP_S5A, 0), ST(OP_S5B, 0), ST(OP_S5Z, 0), ST(OP_GLU, 0), OP_NOP, ST(OP_NORM, 1), ST(OP_SWIGLU, 1), ST(OP_BF16, 1), ST(OP_NORM, 2)},
    {ST(OP_SWIGLU, 0), ST(OP_BF16, 0), ST(OP_NORM, 0), ST(OP_QKV_DA, 0), ST(OP_ATT_DA, 0), ST(OP_BF16, 2), OP_NOP, OP_NOP, ST(OP_NORM, 1), ST(OP_SWIGLU, 1), ST(OP_BF16, 1), ST(OP_NORM, 2)},
    {ST(OP_SWIGLU, 0), ST(OP_BF16, 0), ST(OP_NORM, 0), ST(OP_QKV_NA, 0), ST(OP_ATT_NA, 0), ST(OP_BF16, 2), OP_NOP, OP_NOP, ST(OP_NORM, 1), ST(OP_SWIGLU, 1), ST(OP_BF16, 1), ST(OP_NORM, 2)},
    {ST(OP_SWIGLU, 0), ST(OP_BF16, 0), ST(OP_NORM, 0), ST(OP_BF16, 3) | NOSYNC, ST(OP_BF16, 4), ST(OP_GLA, 0), ST(OP_READOUT, 0), ST(OP_BF16, 5), ST(OP_NORM, 1), ST(OP_SWIGLU, 1), ST(OP_BF16, 1), ST(OP_NORM, 2)},
};

#define GSYNC_CG() do { asm volatile("s_waitcnt vmcnt(0) lgkmcnt(0)" ::: "memory"); grid.sync(); __builtin_amdgcn_fence(__ATOMIC_ACQUIRE, "agent"); asm volatile("s_waitcnt vmcnt(0)" ::: "memory"); } while (0)
#define GSYNC() do { XcdBarrier xb_; xb_.bar = (unsigned*)(F.ws + WS_BAR); xb_.x = xb_xcc_id(); xb_.st = (volatile LAS unsigned*)(F.lds + LDS_BYTES - 1024); xcd_barrier(xb_); } while (0)
__global__ void __launch_bounds__(NTHREADS, 2) mega_fwd(Args args) {
    extern __shared__ __attribute__((aligned(16))) unsigned char lds_raw[];
    cg::grid_group grid = cg::this_grid();
    Frame F;
    F.lds = (LAS unsigned char*)lds_raw;
    F.tid = threadIdx.x; F.lane = F.tid & 63; F.wave = __builtin_amdgcn_readfirstlane(F.tid >> 6); F.G = gridDim.x; F.bid = blockIdx.x;
    F.ptab = (LAS unsigned long long*)(F.lds + LDS_BYTES - 512);
#pragma unroll
    for (int i = 0; i < 37; ++i) { if (F.tid == i) F.ptab[i] = (unsigned long long)args.in[i]; }
    F.out = (GAS float*)args.out; F.ws = (GAS unsigned char*)args.ws;
    __syncthreads();

    if (F.tid < 2) ((volatile LAS unsigned*)(F.lds + LDS_BYTES - 1024))[F.tid] = 0u;
    __syncthreads();
    (void)xcd_barrier_post((unsigned*)(F.ws + WS_BAR), (volatile LAS unsigned*)(F.lds + LDS_BYTES - 1024));
#ifdef PROBE_P0
    phase_p0(F);
    GSYNC_CG();
#endif
    phase_p0(F);
    GSYNC_CG();
    norm_phase(F, MALL, true, nullptr, nullptr, 0.f, 0, 0, INP(6), 0, 0, false);
    GSYNC();
#ifdef PROBE_SYNCS
#pragma unroll 1
    for (int i = 0; i < PROBE_SYNCS; ++i) GSYNC();
#endif

#pragma unroll 1
    for (int li = 0; li < 4; ++li) {
#pragma unroll 1
        for (int st = 0; st < 12; ++st) {
            const int code = PROGRAM[li][st]; const int op = code & 15, sub = (code >> 4) & 15;
            if (op == OP_NOP) continue;
            const int Mrows = (li == 3 && st >= 7) ? MLAT : MALL;
#ifdef PROBE_DOUBLE
            const int reps = ((PROBE_DOUBLE >> op) & 1) ? 2 : 1;
#else
            const int reps = 1;
#endif
#pragma unroll 1
            for (int rep = 0; rep < reps; ++rep) {
            { GAS unsigned char* w_ = F.ws; GAS float* o_ = F.out; int g_ = F.G, b_ = F.bid, wv_ = F.wave, t_ = F.tid; asm volatile("" : "+s"(w_), "+s"(o_), "+s"(g_), "+s"(b_), "+s"(wv_), "+v"(t_));
              F.ws = w_; F.out = o_;
              F.G = g_; F.bid = b_; F.wave = wv_; F.tid = t_; F.lane = t_ & 63; }
            unsigned char* ws = (unsigned char*)F.ws;
            bf16* Hb = (bf16*)(ws + WS_H); bf16* Ub = (bf16*)(ws + WS_U); bf16* Yb = (bf16*)(ws + WS_Y);
            switch (op) {
            case OP_SWIGLU: if constexpr (PH_ON(OP_SWIGLU)) {
                pg8::Gemm g{Hb, (const bf16*)(ws + (sub ? WS_W13B : WS_W13A)), Mrows, 2 * FF, D}; pg8::StaticOrder S; S.init(Mrows, 2 * FF, F.G, F.bid, D);
                pg8::EpiSwiglu E{Ub};
                pg8::gemm_phase<pg8::EpiSwiglu, pg8::StaticOrder, true, true>(F.lds, g, S, E, F.tid);
            } break;
            case OP_BF16: if constexpr (PH_ON(OP_BF16)) {
                const bf16* A = Hb; const bf16* Bt; int N = D, K = D; bf16 *o0 = Yb, *o1 = Yb, *o2 = Yb; const float* bias = nullptr;
                if (sub == 0) { A = Ub; Bt = (const bf16*)(ws + WS_W2A); K = FF; }
                else if (sub == 1) { A = Ub; Bt = (const bf16*)(ws + WS_W2B); K = FF; }
                else if (sub == 2) { Bt = (const bf16*)(ws + WS_WM) + (size_t)3 * D * D; }
                else if (sub == 3) { Bt = (const bf16*)(ws + WS_WM); N = 3 * D; o0 = Ub; o1 = (bf16*)(ws + WS_U + ACT_BYTES); o2 = (bf16*)(ws + WS_U + 2 * ACT_BYTES); }
                else if (sub == 4) { Bt = (const bf16*)(ws + WS_WM) + (size_t)3 * D * D; N = 2 * D; o0 = (bf16*)(unsigned char*)F.out; o1 = (bf16*)(ws + WS_U + 3 * ACT_BYTES); bias = INP(33); }
                else { Bt = (const bf16*)(ws + WS_WM) + (size_t)5 * D * D; }
                const bool split = (Mrows == MALL) && (sub <= 2);
                const pg8::EpiBf16S E{o0, o1, o2, bias, (bf16*)(ws + WS_E)};
                pg8::Gemm g{A, Bt, Mrows, N, K}; pg8::StaticOrder S;
                if (split) S.init(MLAT, N, F.G, F.bid, K, 2, 32, 128); else S.init(Mrows, N, F.G, F.bid, K);
                pg8::gemm_phase<pg8::EpiBf16S, pg8::StaticOrder, true, true>(F.lds, g, S, E, F.tid);
            } break;
            case OP_GLU: if constexpr (PH_ON(OP_GLU)) {
                pg8::Gemm g{Hb, (const bf16*)(ws + WS_WM), MALL, D, D}; pg8::StaticOrder S; S.init(MALL, D, F.G, F.bid, D);
                pg8::EpiGlu E{Hb, Yb, INP(20)};
                pg8::gemm_phase<pg8::EpiGlu, pg8::StaticOrder, true, true>(F.lds, g, S, E, F.tid);
            } break;
            case OP_QKV_DA: if constexpr (PH_ON(OP_QKV_DA)) {
                pg8::Gemm g{Hb, (const bf16*)(ws + WS_WM), MALL, 3 * D, D}; pg8::StaticOrder S; S.init(MALL, 3 * D, F.G, F.bid, D);
                pg8::EpiQKV<0> E{Ub, (bf16*)(ws + WS_U + ACT_BYTES), (bf16*)(ws + WS_U + 2 * ACT_BYTES), (const float*)(ws + WS_ROPE), (const float*)(ws + WS_ROPE) + 4096 * 32};
                pg8::gemm_phase<pg8::EpiQKV<0>, pg8::StaticOrder, true, true>(F.lds, g, S, E, F.tid);
            } break;
            case OP_QKV_NA: if constexpr (PH_ON(OP_QKV_NA)) {
                pg8::Gemm g{Hb, (const bf16*)(ws + WS_WM), MALL, 3 * D, D}; pg8::StaticOrder S; S.init(MALL, 3 * D, F.G, F.bid, D);
                pg8::EpiQKV<1> E{Ub, (bf16*)(ws + WS_U + ACT_BYTES), (bf16*)(ws + WS_U + 2 * ACT_BYTES), nullptr, nullptr};
                pg8::gemm_phase<pg8::EpiQKV<1>, pg8::StaticOrder, true, true>(F.lds, g, S, E, F.tid);
            } break;
            case OP_NORM: if constexpr (PH_ON(OP_NORM)) {
                const bool last = (li == 3);
                if (sub == 0) norm_phase(F, MALL, false, Yb, INP(7) + (li * 3 + 0) * D, 0.5f, li, 0, INP(6) + (li * 3 + 1) * D, li, 1, false, 2);
                else if (sub == 1) norm_phase(F, last ? MLAT : MALL, false, Yb, INP(7) + (li * 3 + 1) * D, 1.0f, li, 1, INP(6) + (li * 3 + 2) * D, li, 2, false, (li == 1 || li == 2) ? 2 : 0);
                else {
                    if (last) norm_phase(F, MLAT, false, Yb, INP(7) + (li * 3 + 2) * D, 0.5f, li, 2, nullptr, 0, 0, true);
                    else { norm_phase(F, MALL, false, Yb, INP(7) + (li * 3 + 2) * D, 0.5f, li, 2, INP(6) + ((li + 1) * 3 + 0) * D, li + 1, 0, false, 2); __syncthreads(); convert_layer(F, li + 1);
#ifdef PROBE_P0
                        __syncthreads(); convert_layer(F, li + 1);
#endif
                    }
                }
            } break;
            case OP_S5A: if constexpr (PH_ON(OP_S5A)) { s5_pass<false>(F); } break;
            case OP_S5B: if constexpr (PH_ON(OP_S5B)) { s5_pass<true>(F); } break;
            case OP_S5Z: if constexpr (PH_ON(OP_S5Z)) { s5_z_phase(F); } break;
            case OP_ATT_DA: if constexpr (PH_ON(OP_ATT_DA)) { att_da_phase(F); } break;
            case OP_ATT_NA: if constexpr (PH_ON(OP_ATT_NA)) { att_na_phase(F); } break;
            case OP_GLA: if constexpr (PH_ON(OP_GLA)) { gla_phase(F); } break;
            case OP_READOUT: if constexpr (PH_ON(OP_READOUT)) { hg_readout_phase(F); } break;
            default: break;
            }
            if (!(code & NOSYNC)) GSYNC();
            }
#ifdef STOP_AT
            if (li * 12 + st == STOP_AT) {
#ifndef DUMP_KIND
#define DUMP_KIND 0
#define DUMP_OFF WS_X
#define DUMP_N 0
#endif
                if (DUMP_KIND == 0) { const _Float16* X = (const _Float16*)(F.ws + WS_X);
                    for (size_t i = (size_t)F.bid * NTHREADS + F.tid; i < (size_t)MLAT * D; i += (size_t)F.G * NTHREADS) F.out[i] = (float)X[i]; }
                else if (DUMP_KIND == 1) { const bf16* P = (const bf16*)(F.ws + DUMP_OFF);
                    for (size_t i = (size_t)F.bid * NTHREADS + F.tid; i < (size_t)MLAT * D; i += (size_t)F.G * NTHREADS) F.out[i] = bf2f(P[i]); }
                else if (DUMP_KIND == 3) { const bf16* P = (const bf16*)(F.ws + DUMP_OFF); const bf16* P2 = P + (size_t)MALL * D;
                    for (size_t i = (size_t)F.bid * NTHREADS + F.tid; i < (size_t)MLAT * D; i += (size_t)F.G * NTHREADS) F.out[i] = bf2f(P[i]) + bf2f(P2[i]); }
                else { const float* P = (const float*)(F.ws + DUMP_OFF);
                    for (size_t i = (size_t)F.bid * NTHREADS + F.tid; i < (size_t)MLAT * D; i += (size_t)F.G * NTHREADS) F.out[i] = (i < (size_t)DUMP_N) ? P[i] : 0.f; }
                return;
            }
#endif
        }
    }
}

extern "C" void kernel_launch(void* const* d_in, const int* in_sizes, int n_in, void* d_out, int out_size, void* d_ws, size_t ws_size, hipStream_t stream) {
    static int grid = 0;
    if (grid == 0) {
        int dev = 0, cus = 0, per_cu = 0;
        (void)hipGetDevice(&dev);
        (void)hipDeviceGetAttribute(&cus, hipDeviceAttributeMultiprocessorCount, dev);
        if (hipFuncSetAttribute((const void*)mega_fwd, hipFuncAttributeMaxDynamicSharedMemorySize, LDS_BYTES) != hipSuccess) fprintf(stderr, "kernel_launch: hipFuncSetAttribute failed\n");
        if (hipOccupancyMaxActiveBlocksPerMultiprocessor(&per_cu, (const void*)mega_fwd, NTHREADS, LDS_BYTES) != hipSuccess || per_cu < 1) { fprintf(stderr, "kernel_launch: occupancy query gave %d\n", per_cu); per_cu = 1; }
        (void)hipGetLastError();
        if (per_cu > 1) per_cu = 1;
        grid = cus * per_cu;
        if (n_in != 37 || ws_size < WS_NEED) fprintf(stderr, "kernel_launch: n_in %d ws %zu (need %zu)\n", n_in, ws_size, (size_t)WS_NEED);
    }
    (void)hipMemsetAsync((char*)d_ws + WS_BAR, 0, 65536, stream);
    Args a{};
    for (int i = 0; i < 37; ++i) a.in[i] = (const float*)d_in[i];
    a.out = (float*)d_out; a.ws = (unsigned char*)d_ws;
    void* kargs[] = {&a};
    hipError_t e = hipLaunchCooperativeKernel((const void*)mega_fwd, dim3(grid), dim3(NTHREADS), kargs, LDS_BYTES, stream);
    if (e != hipSuccess) fprintf(stderr, "kernel_launch: cooperative launch failed: %s (grid %d)\n", hipGetErrorString(e), grid);
}
```

```cpp
#include <hip/hip_runtime.h>
#include <hip/hip_cooperative_groups.h>
#include <cstdio>
#include <cstdint>
namespace cg = cooperative_groups;
namespace pg8 {
#define PG8_LAS __attribute__((address_space(3)))
typedef unsigned short bf16_t;
typedef short bf16x8 __attribute__((ext_vector_type(8)));
typedef float f32x4 __attribute__((ext_vector_type(4)));
typedef unsigned u32x4 __attribute__((ext_vector_type(4)));
constexpr int BM = 256, BK = 64, HALF = 128, HTB = HALF * BK * 2  , STAGE_BYTES = 8 * HTB, NXCD = 8, WGM = 8;

__host__ __device__ __forceinline__ int lds_byte(int r, int c) { const int st = (r >> 4) * 2 + (c >> 5), rr = r & 15, cc = c & 31, ob = rr * 64 + cc * 2; return st * 1024 + (ob ^ (((ob >> 9) & 1) << 5)); }
__host__ __device__ __forceinline__ void stage_rc(int b, int& R, int& C) { const int st = b / 1024, sb = b % 1024, swz = sb ^ (((sb >> 9) & 1) << 5); R = (st >> 1) * 16 + swz / 64; C = (st & 1) * 32 + (swz % 64) / 2; }
__host__ __device__ __forceinline__ int perm32(int rho) { const int n = rho >> 4, i = rho & 15; return 8 * (i >> 2) + 4 * n + (i & 3); }

struct Unit { int pm, pn, kb, nkt, part; };
struct Gemm { const bf16_t* A; const bf16_t* Bt; int M, N, K; };

struct StaticOrder {
    int nM, nN, nwg, G, c;
    int nktf, P, nsp, pm0;
    __host__ __device__ void init(int M, int N, int G_, int c_, int K_, int P_ = 0, int nsp_ = 0, int pm0_ = 0) { nM = M / BM; nN = N / BM; nwg = nM * nN; G = G_; c = c_; nktf = K_ / BK; P = P_; nsp = nsp_; pm0 = pm0_; }
    __host__ __device__ __forceinline__ bool next(int i, Unit& u) const {
        const long L = (long)i * G + c; if (L >= nwg + nsp * P) return false;
        const bool sp = (L >= nwg);
        const int Pd = P > 0 ? P : 1; const int v = sp ? (int)L - nwg : 0, cu = v / Pd, p = v - cu * Pd;
        int wgid = sp ? 0 : (int)L; { const int q = nwg / NXCD, r = nwg % NXCD, xcd = wgid % NXCD, off = wgid / NXCD; wgid = (xcd < r ? xcd * (q + 1) : r * (q + 1) + (xcd - r) * q) + off; }
        const int nig = WGM * nN, gid = wgid / nig, fm = gid * WGM, gsz = (nM - fm) < WGM ? (nM - fm) : WGM;
        const int pm_n = fm + ((wgid % nig) % gsz), pn_n = (wgid % nig) / gsz;
        const int nk_s = nktf / Pd;
        u.pm = sp ? pm0 + cu / nN : pm_n; u.pn = sp ? cu % nN : pn_n; u.nkt = sp ? nk_s : nktf; u.kb = sp ? p * nk_s : 0; u.part = sp ? p : -1;
        return true;
    }
    __device__ __forceinline__ void a_ready(const Unit&) const {}
    __device__ __forceinline__ void done(const Unit&) const {}
};
typedef float f32x2_cv __attribute__((ext_vector_type(2))); typedef __bf16 bf16x2_cv __attribute__((ext_vector_type(2)));
__device__ __forceinline__ unsigned cvt_pk_bf16(float lo, float hi) { f32x2_cv v = {lo, hi}; bf16x2_cv b = __builtin_convertvector(v, bf16x2_cv); return __builtin_bit_cast(unsigned, b); }
typedef unsigned u32x2 __attribute__((ext_vector_type(2)));
#define PG8_GAS __attribute__((address_space(1)))
__device__ __forceinline__ float fast_sigmoid(float x) { return __builtin_amdgcn_rcpf(1.0f + __builtin_amdgcn_exp2f(-1.4426950408889634f * x)); }
__device__ __forceinline__ float bf2f(unsigned short b) { return __uint_as_float(((unsigned)b) << 16); }
constexpr int E_FF = 2816, E_D = 1024, E_TALL = 4352, E_MLAT = 32768;

struct EpiSwiglu {
    static constexpr bool PERM = true, AFTER_DRAIN = false;
    bf16_t* U;
    __device__ __forceinline__ void operator()(const f32x4 (&acc)[2][2][4][2], const Unit& u, int wr, int wc, int fr, int fq) const {
        const int row0 = u.pm * BM + wr * 64 + fr, col0 = u.pn * 128 + wc * 32 + 8 * fq;
#pragma unroll
        for (int ai = 0; ai < 2; ++ai)
#pragma unroll
            for (int m = 0; m < 4; ++m) {
                bf16_t* rowp = U + (size_t)(row0 + ai * HALF + m * 16) * E_FF + col0;
                float r[8];
#pragma unroll
                for (int n = 0; n < 2; ++n)
#pragma unroll
                    for (int j = 0; j < 4; ++j) { const float a = acc[ai][0][m][n][j], g = acc[ai][1][m][n][j]; r[4 * n + j] = a * fast_sigmoid(a) * g; }
                u32x4 w; w.x = cvt_pk_bf16(r[0], r[1]); w.y = cvt_pk_bf16(r[2], r[3]); w.z = cvt_pk_bf16(r[4], r[5]); w.w = cvt_pk_bf16(r[6], r[7]);
                *(u32x4*)rowp = w;
            }
    }
};
struct EpiBf16S {
    static constexpr bool PERM = true, AFTER_DRAIN = false;
    bf16_t *O0, *O1, *O2; const float* bias; bf16_t* OP; bf16_t *O3, *O4; int bias_from;
    __device__ __forceinline__ void operator()(const f32x4 (&acc)[2][2][4][2], const Unit& u, int wr, int wc, int fr, int fq) const {
        const int row0 = u.pm * BM + wr * 64 + fr; const int colt = u.pn * BM; const int t = colt >> 10;
        PG8_GAS bf16_t* base = (PG8_GAS bf16_t*)((unsigned long long)O0 + (unsigned long long)(t == 1) * ((unsigned long long)O1 - (unsigned long long)O0) + (unsigned long long)(t == 2) * ((unsigned long long)O2 - (unsigned long long)O0)
            + (unsigned long long)(t == 3) * ((unsigned long long)O3 - (unsigned long long)O0) + (unsigned long long)(t == 4) * ((unsigned long long)O4 - (unsigned long long)O0));
        if (u.part >= 0) base = (PG8_GAS bf16_t*)OP + ((long)u.part * 2048 - (long)E_MLAT) * E_D;
        const int col0 = (colt & 1023) + wc * 32 + 8 * fq, bcol0 = colt - bias_from + wc * 32 + 8 * fq;
        const bool hasb = (bias != nullptr) && (colt >= bias_from);
        f32x4 bv[2][2];
#pragma unroll
        for (int bj = 0; bj < 2; ++bj)
#pragma unroll
            for (int n = 0; n < 2; ++n) bv[bj][n] = hasb ? *(const f32x4*)(bias + bcol0 + bj * HALF + 4 * n) : (f32x4){0.f, 0.f, 0.f, 0.f};
#pragma unroll
        for (int ai = 0; ai < 2; ++ai)
#pragma unroll
            for (int m = 0; m < 4; ++m) { PG8_GAS bf16_t* rowp = base + (size_t)(row0 + ai * HALF + m * 16) * E_D + col0;
#pragma unroll
                for (int bj = 0; bj < 2; ++bj) { const f32x4 v0 = acc[ai][bj][m][0] + bv[bj][0], v1 = acc[ai][bj][m][1] + bv[bj][1];
                    u32x4 w; w.x = cvt_pk_bf16(v0[0], v0[1]); w.y = cvt_pk_bf16(v0[2], v0[3]); w.z = cvt_pk_bf16(v1[0], v1[1]); w.w = cvt_pk_bf16(v1[2], v1[3]);
                    *(PG8_GAS u32x4*)(rowp + bj * HALF) = w; } }
    }
};
struct EpiGlu {
    static constexpr bool PERM = true, AFTER_DRAIN = false;
    const bf16_t* Z; bf16_t* O; const float* bias;
    __device__ __forceinline__ void operator()(const f32x4 (&acc)[2][2][4][2], const Unit& u, int wr, int wc, int fr, int fq) const {
        const int row0 = u.pm * BM + wr * 64 + fr; const int col0 = u.pn * BM + wc * 32 + 8 * fq;
#pragma unroll
        for (int ai = 0; ai < 2; ++ai)
#pragma unroll
            for (int m = 0; m < 4; ++m) { const size_t ro = (size_t)(row0 + ai * HALF + m * 16) * E_D + col0;
#pragma unroll
                for (int bj = 0; bj < 2; ++bj) {
                    const u32x4 z = *(const u32x4*)(Z + ro + bj * HALF);
                    const f32x4 b0 = *(const f32x4*)(bias + col0 + bj * HALF), b1 = *(const f32x4*)(bias + col0 + bj * HALF + 4);
                    const f32x4 v0 = acc[ai][bj][m][0] + b0, v1 = acc[ai][bj][m][1] + b1;
                    float r[8];
                    const unsigned zz[4] = {z.x, z.y, z.z, z.w};
#pragma unroll
                    for (int j = 0; j < 4; ++j) {
                        const float zl = __uint_as_float(zz[j] << 16), zh = __uint_as_float(zz[j] & 0xffff0000u);
                        const float s0 = fast_sigmoid(j < 2 ? v0[2 * j] : v1[2 * j - 4]), s1 = fast_sigmoid(j < 2 ? v0[2 * j + 1] : v1[2 * j - 3]);
                        r[2 * j] = zl * s0; r[2 * j + 1] = zh * s1; }
                    u32x4 w; w.x = cvt_pk_bf16(r[0], r[1]); w.y = cvt_pk_bf16(r[2], r[3]); w.z = cvt_pk_bf16(r[4], r[5]); w.w = cvt_pk_bf16(r[6], r[7]);
                    *(u32x4*)(O + ro + bj * HALF) = w; } }
    }
};
template <int MODE> struct EpiQKV {
    static constexpr bool PERM = true, AFTER_DRAIN = false;
    bf16_t *Q, *K, *Vt; const float* rcos; const float* rsin;
    __device__ __forceinline__ void operator()(const f32x4 (&acc)[2][2][4][2], const Unit& u, int wr, int wc, int fr, int fq) const {
        const int colt = u.pn * BM; const int sec = colt >> 10;
        const bool lat = (u.pm * BM) < E_MLAT;
#pragma unroll
        for (int ai = 0; ai < 2; ++ai)
#pragma unroll
            for (int m = 0; m < 4; ++m) {
                const int r = u.pm * BM + ai * HALF + wr * 64 + m * 16 + fr;
                int b, t, s;
                if (lat) { b = r >> 12; t = r & 4095; s = 256 + t; } else { const int rr = r - E_MLAT; b = rr >> 8; t = rr & 255; s = t; }
#pragma unroll
                for (int bj = 0; bj < 2; ++bj) {
                    const int cb = (colt & 1023) + bj * HALF + wc * 32 + 8 * fq;
                    float e[8];
#pragma unroll
                    for (int j = 0; j < 4; ++j) { e[j] = acc[ai][bj][m][0][j]; e[4 + j] = acc[ai][bj][m][1][j]; }
                    if (sec < 2) {
                        const int hd = cb >> 6, dd = cb & 63;
                        if (MODE == 0 && lat) {
                            const f32x4 cs = *(const f32x4*)(rcos + t * 32 + (dd >> 1)), sn = *(const f32x4*)(rsin + t * 32 + (dd >> 1));
#pragma unroll
                            for (int j = 0; j < 4; ++j) { const float x1 = e[2 * j], x2 = e[2 * j + 1]; e[2 * j] = x1 * cs[j] - x2 * sn[j]; e[2 * j + 1] = x1 * sn[j] + x2 * cs[j]; }
                        }
                        if (sec == 0) {
#pragma unroll
                            for (int j = 0; j < 8; ++j) e[j] *= 0.125f * 1.4426950408889634f;
                        }
                        bf16_t* dst = (sec ? K : Q) + ((size_t)(b * 16 + hd) * E_TALL + s) * 64 + dd;
                        u32x4 w; w.x = cvt_pk_bf16(e[0], e[1]); w.y = cvt_pk_bf16(e[2], e[3]); w.z = cvt_pk_bf16(e[4], e[5]); w.w = cvt_pk_bf16(e[6], e[7]);
                        *(u32x4*)dst = w;
                    } else {
                        const int vh = (MODE == 0) ? (cb >> 7) : (cb >> 6), dv = (MODE == 0) ? (cb & 127) : (cb & 63);
                        constexpr int NVH = (MODE == 0) ? 8 : 16, DVV = (MODE == 0) ? 128 : 64;
                        bf16_t* dst = Vt + ((size_t)(b * NVH + vh) * DVV + dv) * E_TALL + s;
#pragma unroll
                        for (int j = 0; j < 4; ++j) { const unsigned pk = cvt_pk_bf16(e[2 * j], e[2 * j + 1]); dst[(size_t)(2 * j) * E_TALL] = (bf16_t)(pk & 0xffffu); dst[(size_t)(2 * j + 1) * E_TALL] = (bf16_t)(pk >> 16); }
                    }
                    asm volatile("" ::: "memory");
                }
            }
    }
};
template <class Epi, class Sched, bool ALIGN_EPI = false, bool SP2 = false>
__device__ __forceinline__ void gemm_phase(PG8_LAS unsigned char* lds, const Gemm g, const Sched& S, const Epi& E, const int tid) {
    const int wid = __builtin_amdgcn_readfirstlane(tid >> 6), lane = tid & 63, wr = wid >> 2, wc = wid & 3, fr = lane & 15, fq = lane >> 4;
    const int K = g.K;
    unsigned voffA[2], voffB[2];
#pragma unroll
    for (int i = 0; i < 2; ++i) { int R, C; stage_rc(tid * 16 + i * 8192, R, C); const int Rb = Epi::PERM ? ((R & ~31) + perm32(R & 31)) : R;
        voffA[i] = (unsigned)(R * K + C) * 2u; voffB[i] = (unsigned)(Rb * K + C) * 2u; }
    const size_t kstep = (size_t)(BK * 2);
    const size_t hstep = (size_t)HALF * K * 2;
    const size_t tstep = 2 * hstep;
    const unsigned ldsw = (unsigned)wid * 1024u;
    const int aoff = lds_byte(wr * 64 + fr, fq * 8), boff = lds_byte(wc * 32 + fr, fq * 8);
#define PG8_SA(b, h) (((b) * 2 + (h)) * HTB)
#define PG8_SB(b, h) ((4 + (b) * 2 + (h)) * HTB)
#define PG8_STAGE(bufoff, gbase, voff) do { _Pragma("unroll") for (int _i = 0; _i < 2; ++_i) \
        __builtin_amdgcn_global_load_lds((const unsigned*)((const char*)(gbase) + (voff)[_i]), (PG8_LAS unsigned*)(lds + (bufoff) + ldsw + _i * 8192), 16, 0, 0); } while (0)
#define PG8_LDA(dst, b, h) do { _Pragma("unroll") for (int m = 0; m < 4; ++m) _Pragma("unroll") for (int k = 0; k < 2; ++k) dst[m][k] = *(const PG8_LAS bf16x8*)(lds + PG8_SA(b, h) + aoff + m * 2048 + k * 1024); } while (0)
#define PG8_LDB(dst, b, h) do { _Pragma("unroll") for (int n = 0; n < 2; ++n) _Pragma("unroll") for (int k = 0; k < 2; ++k) dst[n][k] = *(const PG8_LAS bf16x8*)(lds + PG8_SB(b, h) + boff + n * 2048 + k * 1024); } while (0)
#define PG8_MMA(ai, bj, At, Bt) do { __builtin_amdgcn_s_setprio(1); _Pragma("unroll") for (int m = 0; m < 4; ++m) _Pragma("unroll") for (int n = 0; n < 2; ++n) _Pragma("unroll") for (int k = 0; k < 2; ++k) \
        acc[ai][bj][m][n] = __builtin_amdgcn_mfma_f32_16x16x32_bf16(Bt[n][k], At[m][k], acc[ai][bj][m][n], 0, 0, 0); __builtin_amdgcn_s_setprio(0); } while (0)
#define PG8_WAIT_V(n) asm volatile("s_waitcnt vmcnt(" #n ")" ::: "memory")
#define PG8_WAIT_L(n) asm volatile("s_waitcnt lgkmcnt(" #n ")" ::: "memory")
#define PG8_BAR __builtin_amdgcn_s_barrier()
#define PG8_SCHED __builtin_amdgcn_sched_barrier(0)
    Unit cur, nxt; int ui = 0;
    if (!S.next(0, cur)) return;
    f32x4 acc[2][2][4][2];
#pragma unroll
    for (int a = 0; a < 2; ++a)
#pragma unroll
        for (int b = 0; b < 2; ++b)
#pragma unroll
            for (int m = 0; m < 4; ++m)
#pragma unroll
                for (int n = 0; n < 2; ++n) acc[a][b][m][n] = (f32x4){0.f, 0.f, 0.f, 0.f};
    bf16x8 At[4][2], B0[2][2], B1[2][2];
    const char* cA = (const char*)g.A + (size_t)cur.pm * tstep + (size_t)cur.kb * kstep; const char* cB = (const char*)g.Bt + (size_t)cur.pn * tstep + (size_t)cur.kb * kstep;
    S.a_ready(cur);
    if constexpr (SP2) {
        PG8_STAGE(PG8_SB(0, 0), cB, voffB); PG8_STAGE(PG8_SB(0, 1), cB + hstep, voffB); PG8_STAGE(PG8_SA(0, 0), cA, voffA); PG8_STAGE(PG8_SA(0, 1), cA + hstep, voffA);
        if (wr == 1) PG8_BAR;
        PG8_WAIT_V(2); PG8_BAR;
        PG8_STAGE(PG8_SB(1, 0), cB + kstep, voffB); PG8_STAGE(PG8_SA(1, 0), cA + kstep, voffA); PG8_STAGE(PG8_SB(1, 1), cB + hstep + kstep, voffB);
        PG8_WAIT_V(6); PG8_BAR;
    } else {
        PG8_STAGE(PG8_SB(0, 0), cB, voffB); PG8_STAGE(PG8_SA(0, 0), cA, voffA); PG8_STAGE(PG8_SB(0, 1), cB + hstep, voffB); PG8_STAGE(PG8_SA(0, 1), cA + hstep, voffA);
        if (wr == 1) PG8_BAR;
        PG8_WAIT_V(4); PG8_BAR;
        PG8_STAGE(PG8_SB(1, 0), cB + kstep, voffB); PG8_STAGE(PG8_SA(1, 0), cA + kstep, voffA); PG8_STAGE(PG8_SB(1, 1), cB + hstep + kstep, voffB);
        PG8_WAIT_V(6); PG8_BAR;
    }
    for (;;) {
        const bool has_next = S.next(ui + 1, nxt);
        const char* nA = has_next ? (const char*)g.A + (size_t)nxt.pm * tstep + (size_t)nxt.kb * kstep : cA; const char* nB = has_next ? (const char*)g.Bt + (size_t)nxt.pn * tstep + (size_t)nxt.kb * kstep : cB;
        const int nt = cur.nkt;
        for (int t = 0; t < nt; t += 2) {
            const bool last = (t == nt - 2);
            const char* a1 = cA + (size_t)(t + 1) * kstep;
            const char* a2 = last ? nA : cA + (size_t)(t + 2) * kstep; const char* b2 = last ? nB : cB + (size_t)(t + 2) * kstep;
            const char* a3 = a2 + kstep; const char* b3 = b2 + kstep;
            if (last && has_next) S.a_ready(nxt);
            if constexpr (SP2) {
            PG8_LDB(B0, 0, 0); PG8_LDB(B1, 0, 1); PG8_SCHED; PG8_LDA(At, 0, 0); PG8_STAGE(PG8_SA(1, 1), a1 + hstep, voffA);
            PG8_WAIT_V(8); PG8_WAIT_L(0); PG8_BAR; PG8_MMA(0, 0, At, B0); PG8_MMA(0, 1, At, B1); PG8_BAR; PG8_SCHED;
            PG8_LDA(At, 0, 1); PG8_STAGE(PG8_SB(0, 0), b2, voffB); PG8_STAGE(PG8_SB(0, 1), b2 + hstep, voffB); PG8_STAGE(PG8_SA(0, 0), a2, voffA);
            PG8_WAIT_V(8); PG8_WAIT_L(0); PG8_BAR; PG8_MMA(1, 0, At, B0); PG8_MMA(1, 1, At, B1); PG8_BAR; PG8_SCHED;
            PG8_LDB(B0, 1, 0); PG8_LDB(B1, 1, 1); PG8_SCHED; PG8_LDA(At, 1, 0); PG8_STAGE(PG8_SA(0, 1), a2 + hstep, voffA);
            PG8_WAIT_V(8); PG8_WAIT_L(0); PG8_BAR; PG8_MMA(0, 0, At, B0); PG8_MMA(0, 1, At, B1); PG8_BAR; PG8_SCHED;
            PG8_LDA(At, 1, 1); PG8_STAGE(PG8_SB(1, 0), b3, voffB); PG8_STAGE(PG8_SB(1, 1), b3 + hstep, voffB); PG8_STAGE(PG8_SA(1, 0), a3, voffA);
            PG8_WAIT_V(8); PG8_WAIT_L(0); PG8_BAR; PG8_MMA(1, 0, At, B0); PG8_MMA(1, 1, At, B1); PG8_BAR; PG8_SCHED;
            } else {
            PG8_LDB(B0, 0, 0); PG8_SCHED; PG8_LDA(At, 0, 0); PG8_STAGE(PG8_SA(1, 1), a1 + hstep, voffA);
            PG8_WAIT_L(8); PG8_BAR; PG8_WAIT_L(0); PG8_MMA(0, 0, At, B0); PG8_BAR; PG8_SCHED;
            PG8_LDB(B1, 0, 1); PG8_STAGE(PG8_SB(0, 0), b2, voffB);
            PG8_BAR; PG8_WAIT_L(0); PG8_MMA(0, 1, At, B1); PG8_BAR;
            PG8_LDA(At, 0, 1); PG8_STAGE(PG8_SA(0, 0), a2, voffA);
            PG8_BAR; PG8_WAIT_L(0); PG8_MMA(1, 0, At, B0); PG8_BAR; PG8_SCHED;
            PG8_STAGE(PG8_SB(0, 1), b2 + hstep, voffB);
            PG8_WAIT_V(6); PG8_BAR; PG8_MMA(1, 1, At, B1); PG8_BAR;
            PG8_LDB(B0, 1, 0); PG8_SCHED; PG8_LDA(At, 1, 0); PG8_STAGE(PG8_SA(0, 1), a2 + hstep, voffA);
            PG8_WAIT_L(8); PG8_BAR; PG8_WAIT_L(0); PG8_MMA(0, 0, At, B0); PG8_BAR; PG8_SCHED;
            PG8_LDB(B1, 1, 1); PG8_STAGE(PG8_SB(1, 0), b3, voffB);
            PG8_BAR; PG8_WAIT_L(0); PG8_MMA(0, 1, At, B1); PG8_BAR;
            PG8_LDA(At, 1, 1); PG8_STAGE(PG8_SA(1, 0), a3, voffA);
            PG8_BAR; PG8_WAIT_L(0); PG8_MMA(1, 0, At, B0); PG8_BAR; PG8_SCHED;
            PG8_STAGE(PG8_SB(1, 1), b3 + hstep, voffB);
            PG8_WAIT_V(6); PG8_BAR; PG8_MMA(1, 1, At, B1); PG8_BAR;
            }
        }
        if constexpr (ALIGN_EPI) { if (wr == 0) PG8_BAR; }
        if constexpr (!Epi::AFTER_DRAIN) { E(acc, cur, wr, wc, fr, fq); S.done(cur); }
        if (!has_next) break;
#pragma unroll
        for (int a = 0; a < 2; ++a)
#pragma unroll
            for (int b = 0; b < 2; ++b)
#pragma unroll
                for (int m = 0; m < 4; ++m)
#pragma unroll
                    for (int n = 0; n < 2; ++n) acc[a][b][m][n] = (f32x4){0.f, 0.f, 0.f, 0.f};
        cur = nxt; cA = nA; cB = nB; ++ui;
        if constexpr (ALIGN_EPI) { if (wr == 1) PG8_BAR; }
    }
    PG8_WAIT_V(0);
    if constexpr (!ALIGN_EPI) { if (wr == 0) PG8_BAR; }
    PG8_BAR;
    if constexpr (Epi::AFTER_DRAIN) { E.fused(acc, cur, wr, wc, fr, fq, lds, wid, lane); S.done(cur); }
#undef PG8_SA
#undef PG8_SB
#undef PG8_STAGE
#undef PG8_LDA
#undef PG8_LDB
#undef PG8_MMA
#undef PG8_WAIT_V
#undef PG8_WAIT_L
#undef PG8_BAR
#undef PG8_SCHED
}
}
#define LAS __attribute__((address_space(3)))
#define GAS __attribute__((address_space(1)))
typedef unsigned short bf16;
typedef float f32x4 __attribute__((ext_vector_type(4)));
typedef float f32x16 __attribute__((ext_vector_type(16)));
typedef short bf16x8 __attribute__((ext_vector_type(8)));
typedef short s16x4 __attribute__((ext_vector_type(4)));
typedef unsigned u32x4 __attribute__((ext_vector_type(4)));
typedef unsigned u32x2 __attribute__((ext_vector_type(2)));
typedef _Float16 h16x4 __attribute__((ext_vector_type(4)));

constexpr int D = 1024, NB = 8, SEQ = 4096, CTX = 256, TALL = 4352, MLAT = NB * SEQ, MCTX = NB * CTX, MALL = MLAT + MCTX, FF = 2816;
constexpr float RMS_EPS = 1e-6f, LOG2E = 1.4426950408889634f;
constexpr int NTHREADS = 512, NWAVES = 8;
constexpr int LDS_BYTES = 147456;

constexpr size_t MiB = 1u << 20;
constexpr size_t WS_BAR = 0;
constexpr size_t WS_MOD = 1 * MiB;
constexpr size_t WS_ROPE = 3 * MiB;
constexpr size_t WS_S5LAM = 4 * MiB;
constexpr size_t WS_S5B = 4 * MiB + 256 * 1024;
constexpr size_t WS_S5C = 5 * MiB;
constexpr size_t WS_W13A = 8 * MiB, WS_W2A = 19 * MiB, WS_W13B = 25 * MiB, WS_W2B = 36 * MiB, WS_WM = 42 * MiB;
constexpr size_t WS_X = 56 * MiB;
constexpr size_t WS_H = 192 * MiB;
constexpr size_t WS_U = 260 * MiB;
constexpr size_t WS_Y = 447 * MiB;
constexpr size_t WS_E = 515 * MiB;
constexpr size_t ACT_BYTES = (size_t)MALL * D * 2;
constexpr size_t WS_NEED = 600 * MiB;

struct Args { const float* in[37]; float* out; unsigned char* ws; };

struct Frame {
    LAS unsigned char* lds;
    int tid, lane, wave, G, bid;
    LAS unsigned long long* ptab; GAS float* out; GAS unsigned char* ws;
};
__device__ __forceinline__ const float* inp_(const Frame& F, int i) { const unsigned long long v = F.ptab[i]; const unsigned lo = __builtin_amdgcn_readfirstlane((unsigned)v), hi = __builtin_amdgcn_readfirstlane((unsigned)(v >> 32)); return (const float*)(GAS const float*)(((unsigned long long)hi << 32) | lo); }
#define INP(i) inp_(F, (i))

__device__ __forceinline__ unsigned f2bf(float f) { unsigned u = __builtin_bit_cast(unsigned, f); return (u + 0x7fffu + ((u >> 16) & 1u)) >> 16; }
__device__ __forceinline__ unsigned pk2(float lo, float hi) { return pg8::cvt_pk_bf16(lo, hi); }
__device__ __forceinline__ float bf2f(unsigned short b) { return __uint_as_float(((unsigned)b) << 16); }
__device__ __forceinline__ float bflo(unsigned w) { return __uint_as_float(w << 16); }
__device__ __forceinline__ float bfhi(unsigned w) { return __uint_as_float(w & 0xffff0000u); }
__device__ __forceinline__ float wave_sum(float v) {
#pragma unroll
    for (int o = 1; o < 64; o <<= 1) v += __shfl_xor(v, o);
    return v;
}
__device__ __forceinline__ float fexp(float x) { return __builtin_amdgcn_exp2f(x * LOG2E); }
__device__ __forceinline__ float fsigmoid(float x) { return __builtin_amdgcn_rcpf(1.0f + __builtin_amdgcn_exp2f(-LOG2E * x)); }
__device__ __forceinline__ int crow(int r, int hi) { return (r & 3) + 8 * (r >> 2) + 4 * hi; }
#define LBAR() asm volatile("s_waitcnt lgkmcnt(0)\n\ts_barrier" ::: "memory")
#define MFMA32(a, b, c) __builtin_amdgcn_mfma_f32_32x32x16_bf16((a), (b), (c), 0, 0, 0)
#define MFMA16(a, b, c) __builtin_amdgcn_mfma_f32_16x16x32_bf16((a), (b), (c), 0, 0, 0)

__device__ __forceinline__ void cvt_item(const float* W, int K, int N, bf16* WT, int mode, int row_off, LAS float* scr, int item, int lane) {
    const int nblk = N / 32, kb = item / nblk, nb = item % nblk, k0 = 64 * kb, n0 = 32 * nb;
#pragma unroll
    for (int i = 0; i < 8; ++i) { const int kk = 8 * i + (lane >> 3), c4 = 4 * (lane & 7);
        const f32x4 v = *(const f32x4*)(W + (size_t)(k0 + kk) * N + n0 + c4);
        scr[kk * 33 + c4] = v[0]; scr[kk * 33 + c4 + 1] = v[1]; scr[kk * 33 + c4 + 2] = v[2]; scr[kk * 33 + c4 + 3] = v[3]; }
    asm volatile("s_waitcnt lgkmcnt(0)" ::: "memory");
    const int c = lane & 7;
    const int drow0 = (mode == 0) ? (row_off + n0) : ((n0 >> 7) * 256 + (mode - 1) * 128 + (n0 & 127));
#pragma unroll
    for (int j = 0; j < 4; ++j) { const int n = (lane >> 3) + 8 * j; const LAS float* s = scr + (8 * c) * 33 + n;
        u32x4 o; o.x = pk2(s[0 * 33], s[1 * 33]); o.y = pk2(s[2 * 33], s[3 * 33]); o.z = pk2(s[4 * 33], s[5 * 33]); o.w = pk2(s[6 * 33], s[7 * 33]);
        *(u32x4*)(WT + (size_t)(drow0 + n) * K + k0 + 8 * c) = o; }
    asm volatile("s_waitcnt lgkmcnt(0)" ::: "memory");
}
__device__ __forceinline__ void convert_layer(Frame& F, int li) {
    LAS float* scr = (LAS float*)(F.lds + F.wave * 16384);
    const int gw = F.bid * NWAVES + F.wave, NGW = F.G * NWAVES;
    constexpr int I_UP = (D / 64) * (FF / 32), I_DN = (FF / 64) * (D / 32), I_SQ = (D / 64) * (D / 32);
    const int n_mix = (li == 0) ? I_SQ : (li == 3 ? 6 * I_SQ : 4 * I_SQ);
    const int NITEMS = 4 * I_UP + 2 * I_DN + n_mix;
    bf16* w13a = (bf16*)(F.ws + WS_W13A); bf16* w2a = (bf16*)(F.ws + WS_W2A); bf16* w13b = (bf16*)(F.ws + WS_W13B); bf16* w2b = (bf16*)(F.ws + WS_W2B); bf16* wm = (bf16*)(F.ws + WS_WM);
    const size_t offA = (size_t)(li * 2 + 0) * D * FF, offB = (size_t)(li * 2 + 1) * D * FF;
    for (int it = gw; it < NITEMS; it += NGW) {
        int r = it;
        if (r < I_UP) { cvt_item(INP(8) + offA, D, FF, w13a, 1, 0, scr, r, F.lane); continue; } r -= I_UP;
        if (r < I_UP) { cvt_item(INP(9) + offA, D, FF, w13a, 2, 0, scr, r, F.lane); continue; } r -= I_UP;
        if (r < I_DN) { cvt_item(INP(10) + offA, FF, D, w2a, 0, 0, scr, r, F.lane); continue; } r -= I_DN;
        if (r < I_UP) { cvt_item(INP(8) + offB, D, FF, w13b, 1, 0, scr, r, F.lane); continue; } r -= I_UP;
        if (r < I_UP) { cvt_item(INP(9) + offB, D, FF, w13b, 2, 0, scr, r, F.lane); continue; } r -= I_UP;
        if (r < I_DN) { cvt_item(INP(10) + offB, FF, D, w2b, 0, 0, scr, r, F.lane); continue; } r -= I_DN;
        if (li == 0) { cvt_item(INP(19), D, D, wm, 0, 0, scr, r, F.lane); continue; }
        if (li == 1 || li == 2) {
            const float* wqkv = INP(li == 1 ? 21 : 28); const float* wo = INP(li == 1 ? 22 : 29);
            if (r < 3 * I_SQ) { cvt_item(wqkv, D, 3 * D, wm, 0, 0, scr, r, F.lane); continue; } r -= 3 * I_SQ;
            cvt_item(wo, D, D, wm + (size_t)3 * D * D, 0, 0, scr, r, F.lane); continue;
        }
        if (r < 3 * I_SQ) { cvt_item(INP(31), D, 3 * D, wm, 0, 0, scr, r, F.lane); continue; } r -= 3 * I_SQ;
        if (r < I_SQ) { cvt_item(INP(32), D, D, wm + (size_t)3 * D * D, 0, 0, scr, r, F.lane); continue; } r -= I_SQ;
        if (r < I_SQ) { cvt_item(INP(32) + (size_t)D * D, D, D, wm + (size_t)4 * D * D, 0, 0, scr, r, F.lane); continue; } r -= I_SQ;
        cvt_item(INP(36), D, D, wm + (size_t)5 * D * D, 0, 0, scr, r, F.lane);
    }
}

__device__ __forceinline__ void phase_p0(Frame& F) {
    {
        LAS float* sc = (LAS float*)F.lds;
        LAS float* red = (LAS float*)(F.lds + 40960);
        for (int i = F.tid; i < 9 * 1024; i += NTHREADS) { const int bi = i >> 10, k = i & 1023; const float v = (bi < 8) ? INP(1)[bi * 1024 + k] : INP(3)[k]; sc[i] = v * fsigmoid(v); }
        __syncthreads();
        float* MOD = (float*)(F.ws + WS_MOD);
        const int col = F.tid & 31, ks = F.tid >> 5;
        for (int u = F.bid; u < 4 * 288; u += F.G) {
            const int li = u / 288, c0 = (u % 288) * 32;
            const float* W = INP(4) + (size_t)li * D * 9216 + c0 + col;
            float acc[9];
#pragma unroll
            for (int b = 0; b < 9; ++b) acc[b] = 0.f;
#pragma unroll 2
            for (int k4 = 0; k4 < 16; ++k4) {
                const int k = ks * 64 + k4 * 4;
                const float w0 = W[(size_t)(k + 0) * 9216], w1 = W[(size_t)(k + 1) * 9216], w2 = W[(size_t)(k + 2) * 9216], w3 = W[(size_t)(k + 3) * 9216];
#pragma unroll
                for (int b = 0; b < 9; ++b) { const f32x4 s = *(const LAS f32x4*)(sc + b * 1024 + k); acc[b] += s[0] * w0 + s[1] * w1 + s[2] * w2 + s[3] * w3; }
            }
#pragma unroll
            for (int b = 0; b < 9; ++b) red[(ks * 9 + b) * 32 + col] = acc[b];
            __syncthreads();
            if (F.tid < 288) { const int b = F.tid >> 5, cc = F.tid & 31; float s = 0.f;
#pragma unroll
                for (int q = 0; q < 16; ++q) s += red[(q * 9 + b) * 32 + cc];
                MOD[(size_t)(li * 9 + b) * 9216 + c0 + cc] = s + INP(5)[li * 9216 + c0 + cc]; }
            __syncthreads();
        }
    }
    const int gt = F.bid * NTHREADS + F.tid, NGT = F.G * NTHREADS;
    {
        float* rc = (float*)(F.ws + WS_ROPE); float* rs = rc + 4096 * 32;
        for (int i = gt; i < 4096 * 32; i += NGT) { const int t = i >> 5, p = i & 31;
            const float inv = exp2f(-(float)(p & 15) * (13.287712379549449f / 16.0f));
            const float pos = (p < 16) ? (float)(t >> 6) : (float)(t & 63);
            float s, c; sincosf(pos * inv, &s, &c); rc[i] = c; rs[i] = s; }
    }
    {
        float* LAM = (float*)(F.ws + WS_S5LAM); bf16* BM_ = (bf16*)(F.ws + WS_S5B); bf16* CM_ = (bf16*)(F.ws + WS_S5C);
        const float *a_re = INP(11), *a_im = INP(12), *ldt = INP(13), *b_re = INP(14), *b_im = INP(15), *c_re = INP(16), *c_im = INP(17);
        for (int i = gt; i < 2 * 64 * 64; i += NGT) { const int dg = i >> 6;
            const float dt = expf(ldt[dg]); const float ar = a_re[i], ai = a_im[i];
            const float mag = expf(ar * dt); float s, c; sincosf(ai * dt, &s, &c);
            LAM[2 * i] = mag * c; LAM[2 * i + 1] = mag * s; }
        for (int i = gt; i < 2 * 64 * 4 * 64 * 8; i += NGT) {
            const int j = i & 7, ln = (i >> 3) & 63, cb = (i >> 9) & 3, dg = i >> 11;
            const int p = (ln & 31) + 32 * (cb >> 1), n = 8 * (ln >> 5) + j;
            const int ip = dg * 64 + p;
            const float dt = expf(ldt[dg]); const float ar = a_re[ip], ai = a_im[ip];
            const float mag = expf(ar * dt); float s, c; sincosf(ai * dt, &s, &c);
            const float nr = mag * c - 1.0f, ni = mag * s;
            const float den = 1.0f / (ar * ar + ai * ai);
            const float qr = (nr * ar + ni * ai) * den, qi = (ni * ar - nr * ai) * den;
            const float br = b_re[(size_t)ip * 16 + n], bi = b_im[(size_t)ip * 16 + n];
            const float vr = qr * br - qi * bi, vi = qr * bi + qi * br;
            BM_[i] = (bf16)f2bf((cb & 1) ? vi : vr);
        }
        for (int i = gt; i < 2 * 64 * 4 * 64 * 8; i += NGT) {
            const int j = i & 7, ln = (i >> 3) & 63, kc = (i >> 9) & 3, dg = i >> 11;
            const int n = ln & 15, p = 16 * kc + 4 * (ln >> 4) + (j >> 1);
            const size_t ic = ((size_t)dg * 16 + n) * 64 + p;
            CM_[i] = (bf16)f2bf((j & 1) ? -c_im[ic] : c_re[ic]);
        }
    }
    __syncthreads();
    convert_layer(F, 0);
}

__device__ __forceinline__ void norm_phase(Frame& F, int nrows, bool init, const bf16* Y, const float* gpost, float wgt, int mli, int mj, const float* gpre, int nli, int nj, bool fin, int ysplit = 0) {
    const int gw = F.bid * NWAVES + F.wave, NGW = F.G * NWAVES;
    _Float16* X = (_Float16*)(F.ws + WS_X); bf16* H = (bf16*)(F.ws + WS_H); const float* MOD = (const float*)(F.ws + WS_MOD);
    const int lo = 4 * F.lane;
    const int nlat = nrows < MLAT ? nrows : MLAT;
    const int chunk = (nlat + NGW - 1) / NGW;
    const int rbeg = gw * chunk, rend = (rbeg + chunk < nlat) ? rbeg + chunk : nlat;
    int crow = MLAT + gw; bool ctxmode = false;
    f32x4 pg[4], ps1[4], ps0[4], cgp[4], cgr[4];
    int cur_bi = -1;
    u32x2 pxr[2][4], pyr[2][4]; int pf_row = -1;
#pragma unroll
    for (int j = 0; j < 4; ++j) { cgp[j] = Y ? *(const f32x4*)(gpost + lo + 256 * j) : (f32x4){0.f, 0.f, 0.f, 0.f}; cgr[j] = gpre ? *(const f32x4*)(gpre + lo + 256 * j) : (f32x4){0.f, 0.f, 0.f, 0.f}; }
    for (int row0 = rbeg;; row0 += 2) {
        if (!ctxmode && row0 >= rend) ctxmode = true;
        if (ctxmode) { if (crow >= nrows) break; row0 = crow; crow += NGW; }
        const bool has1 = !ctxmode && (row0 + 1 < rend) && (((row0 + 1) >> 12) == (row0 >> 12));
        const int bi = (row0 < MLAT) ? (row0 >> 12) : 8;
        if (bi != cur_bi) {
            cur_bi = bi;
            const float* gate = MOD + (size_t)(mli * 9 + bi) * 9216 + (mj * 3 + 2) * 1024;
            const float* sh = MOD + (size_t)(nli * 9 + bi) * 9216 + (nj * 3 + 0) * 1024;
#pragma unroll
            for (int j = 0; j < 4; ++j) {
                if (Y) pg[j] = *(const f32x4*)(gate + lo + 256 * j) * cgp[j] * wgt;
                if (gpre) { ps1[j] = (*(const f32x4*)(sh + 1024 + lo + 256 * j) + 1.0f) * cgr[j]; ps0[j] = *(const f32x4*)(sh + lo + 256 * j); }
            }
        }
        const int rows[2] = {row0, has1 ? row0 + 1 : row0};
        f32x4 x[2][4], y[2][4];
        const bool regular = !init && !ctxmode && has1 && (Y != nullptr);
        if (regular) {
            u32x2 cx[2][4], cy[2][4];
            if (pf_row == row0) {
#pragma unroll
                for (int q = 0; q < 2; ++q)
#pragma unroll
                    for (int j = 0; j < 4; ++j) { cx[q][j] = pxr[q][j]; cy[q][j] = pyr[q][j]; }
            } else {
#pragma unroll
                for (int q = 0; q < 2; ++q)
#pragma unroll
                    for (int j = 0; j < 4; ++j) { cx[q][j] = *(const u32x2*)(X + (size_t)(row0 + q) * D + lo + 256 * j); cy[q][j] = *(const u32x2*)(Y + (size_t)(row0 + q) * D + lo + 256 * j); }
            }
            const int nr = row0 + 2;
            if (nr + 1 < rend && (((nr + 1) >> 12) == (row0 >> 12))) {
#pragma unroll
                for (int q = 0; q < 2; ++q)
#pragma unroll
                    for (int j = 0; j < 4; ++j) { pxr[q][j] = *(const u32x2*)(X + (size_t)(nr + q) * D + lo + 256 * j); pyr[q][j] = *(const u32x2*)(Y + (size_t)(nr + q) * D + lo + 256 * j); }
                pf_row = nr;
            } else pf_row = -1;
#pragma unroll
            for (int q = 0; q < 2; ++q)
#pragma unroll
                for (int j = 0; j < 4; ++j) {
                    x[q][j] = __builtin_convertvector(__builtin_bit_cast(h16x4, cx[q][j]), f32x4);
                    y[q][j] = (f32x4){bflo(cy[q][j].x), bfhi(cy[q][j].x), bflo(cy[q][j].y), bfhi(cy[q][j].y)};
                }
        } else
#pragma unroll
        for (int q = 0; q < 2; ++q) {
            const int row = rows[q];
            if (init) {
                const float* src = (row < MLAT) ? INP(0) + (size_t)row * D : INP(2) + (size_t)(row - MLAT) * D;
#pragma unroll
                for (int j = 0; j < 4; ++j) x[q][j] = *(const f32x4*)(src + lo + 256 * j);
            } else {
#pragma unroll
                for (int j = 0; j < 4; ++j) x[q][j] = __builtin_convertvector(*(const h16x4*)(X + (size_t)row * D + lo + 256 * j), f32x4);
            }
            if (Y) {
                if (ysplit > 0 && row >= MLAT) {
                    const bf16* yp = (const bf16*)(F.ws + WS_E) + (size_t)(row - MLAT) * D + lo;
#pragma unroll
                    for (int j = 0; j < 4; ++j) y[q][j] = (f32x4){0.f, 0.f, 0.f, 0.f};
                    for (int p0 = 0; p0 < ysplit; p0 += 4) {
                        u32x2 w[4][4];
#pragma unroll
                        for (int pp = 0; pp < 4; ++pp) { const int p = (p0 + pp < ysplit) ? p0 + pp : p0;
#pragma unroll
                            for (int j = 0; j < 4; ++j) w[pp][j] = *(const u32x2*)(yp + (size_t)p * 2048 * D + 256 * j); }
#pragma unroll
                        for (int pp = 0; pp < 4; ++pp) if (p0 + pp < ysplit) {
#pragma unroll
                            for (int j = 0; j < 4; ++j) y[q][j] = y[q][j] + (f32x4){bflo(w[pp][j].x), bfhi(w[pp][j].x), bflo(w[pp][j].y), bfhi(w[pp][j].y)}; }
                    }
                } else {
#pragma unroll
                    for (int j = 0; j < 4; ++j) { const u32x2 w = *(const u32x2*)(Y + (size_t)row * D + lo + 256 * j); y[q][j] = (f32x4){bflo(w.x), bfhi(w.x), bflo(w.y), bfhi(w.y)}; }
                }
            }
        }
        if (Y) {
            float ss[2];
#pragma unroll
            for (int q = 0; q < 2; ++q) { ss[q] = 0.f;
#pragma unroll
                for (int j = 0; j < 4; ++j) ss[q] += y[q][j][0] * y[q][j][0] + y[q][j][1] * y[q][j][1] + y[q][j][2] * y[q][j][2] + y[q][j][3] * y[q][j][3]; }
#pragma unroll
            for (int o = 1; o < 64; o <<= 1) { ss[0] += __shfl_xor(ss[0], o); ss[1] += __shfl_xor(ss[1], o); }
#pragma unroll
            for (int q = 0; q < 2; ++q) {
                const float rstd = rsqrtf(ss[q] * (1.0f / D) + RMS_EPS);
#pragma unroll
                for (int j = 0; j < 4; ++j) x[q][j] = x[q][j] + pg[j] * y[q][j] * rstd;
            }
        }
#pragma unroll
        for (int q = 0; q < 2; ++q) {
            if (q == 1 && !has1) break;
            if (fin) {
#pragma unroll
                for (int j = 0; j < 4; ++j) *(f32x4*)((float*)F.out + (size_t)rows[q] * D + lo + 256 * j) = x[q][j];
            } else {
#pragma unroll
                for (int j = 0; j < 4; ++j) *(h16x4*)(X + (size_t)rows[q] * D + lo + 256 * j) = __builtin_convertvector(x[q][j], h16x4);
            }
        }
        if (gpre) {
            float ss[2];
#pragma unroll
            for (int q = 0; q < 2; ++q) { ss[q] = 0.f;
#pragma unroll
                for (int j = 0; j < 4; ++j) ss[q] += x[q][j][0] * x[q][j][0] + x[q][j][1] * x[q][j][1] + x[q][j][2] * x[q][j][2] + x[q][j][3] * x[q][j][3]; }
#pragma unroll
            for (int o = 1; o < 64; o <<= 1) { ss[0] += __shfl_xor(ss[0], o); ss[1] += __shfl_xor(ss[1], o); }
#pragma unroll
            for (int q = 0; q < 2; ++q) {
                if (q == 1 && !has1) break;
                const float rstd = rsqrtf(ss[q] * (1.0f / D) + RMS_EPS);
#pragma unroll
                for (int j = 0; j < 4; ++j) {
                    const f32x4 h = x[q][j] * rstd * ps1[j] + ps0[j];
                    u32x2 w; w.x = pk2(h[0], h[1]); w.y = pk2(h[2], h[3]);
                    *(u32x2*)(H + (size_t)rows[q] * D + lo + 256 * j) = w; }
            }
        }
        if (!ctxmode && !has1 && row0 + 1 < rend) row0 -= 1;
    }
}

__device__ __forceinline__ float xhalf(float v, int owner) {
    const auto rr = __builtin_amdgcn_permlane32_swap(__float_as_uint(v), __float_as_uint(v), false, false);
    return __uint_as_float(owner ? rr[1] : rr[0]);
}
__device__ __forceinline__ int s5_row(int b, int dir, int jj) {
    if (jj < 256) return MLAT + b * 256 + (dir ? 255 - jj : jj);
    const int t = jj - 256; return b * 4096 + (dir ? 4095 - t : t);
}
template <bool OUTPUT>
__device__ __forceinline__ void s5_pass(Frame& F) {
    const bf16* H = (const bf16*)(F.ws + WS_H);
    const float* LAM = (const float*)(F.ws + WS_S5LAM); const bf16x8* BMv = (const bf16x8*)(F.ws + WS_S5B); const bf16x8* CMv = (const bf16x8*)(F.ws + WS_S5C);
    float* EST = (float*)(F.ws + WS_U + 2 * ACT_BYTES);
    bf16* Y0 = (bf16*)(F.ws + WS_U); bf16* Y1 = (bf16*)(F.ws + WS_U + ACT_BYTES);
    const int lane = F.lane, pc = lane & 31, hi = lane >> 5;
    LAS unsigned* hm = (LAS unsigned*)(F.lds + F.wave * 8704);
    for (int bu = F.bid; bu < 8 * 2 * 17 * 8; bu += F.G) {
        const int g = 8 * (bu & 7) + F.wave; const int sc = (bu >> 3) % 17; const int bd = (bu >> 3) / 17; const int dir = bd & 1, b = bd >> 1;
        const int dg = dir * 64 + g;
        bf16x8 bfr[4], cfr[4];
#pragma unroll
        for (int q = 0; q < 4; ++q) { bfr[q] = BMv[(dg * 4 + q) * 64 + lane]; if (OUTPUT) cfr[q] = CMv[(dg * 4 + q) * 64 + lane]; }
        const float l0r = LAM[(dg * 64 + pc) * 2], l0i = LAM[(dg * 64 + pc) * 2 + 1], l1r = LAM[(dg * 64 + pc + 32) * 2], l1i = LAM[(dg * 64 + pc + 32) * 2 + 1];
        float h0r = 0.f, h0i = 0.f, h1r = 0.f, h1i = 0.f;
        const size_t ebase = (((size_t)(b * 2 + dir) * 17) * 64 + g) * 128;
        if (OUTPUT) {
            float p0r = l0r, p0i = l0i, p1r = l1r, p1i = l1i;
#pragma unroll
            for (int q = 0; q < 8; ++q) { float t = p0r * p0r - p0i * p0i; p0i = 2.f * p0r * p0i; p0r = t; t = p1r * p1r - p1i * p1i; p1i = 2.f * p1r * p1i; p1r = t; }
            for (int c = 0; c < sc; ++c) {
                const float* e = EST + ebase + (size_t)c * 64 * 128;
                const float e0r = e[pc * 2], e0i = e[pc * 2 + 1], e1r = e[(pc + 32) * 2], e1i = e[(pc + 32) * 2 + 1];
                float t = p0r * h0r - p0i * h0i + e0r; h0i = p0r * h0i + p0i * h0r + e0i; h0r = t;
                t = p1r * h1r - p1i * h1i + e1r; h1i = p1r * h1i + p1i * h1r + e1i; h1r = t;
            }
        }
        bf16x8 ua_next = *(const bf16x8*)(H + (size_t)s5_row(b, dir, sc * 256 + pc) * D + g * 16 + 8 * hi);
        for (int sub = 0; sub < 8; ++sub) {
            const int j0 = sc * 256 + sub * 32;
            const bf16x8 ua = ua_next;
            if (sub + 1 < 8) ua_next = *(const bf16x8*)(H + (size_t)s5_row(b, dir, j0 + 32 + pc) * D + g * 16 + 8 * hi);
            f32x16 d0 = {}, d1 = {}, d2 = {}, d3 = {};
            d0 = MFMA32(ua, bfr[0], d0); d1 = MFMA32(ua, bfr[1], d1); d2 = MFMA32(ua, bfr[2], d2); d3 = MFMA32(ua, bfr[3], d3);
#pragma unroll
            for (int run = 0; run < 8; ++run) {
                const int owner = run & 1, rb = 4 * (run >> 1);
#pragma unroll
                for (int i = 0; i < 4; ++i) {
                    const int r = rb + i;
                    float t = l0r * h0r - l0i * h0i + d0[r]; h0i = l0r * h0i + l0i * h0r + d1[r]; h0r = t;
                    t = l1r * h1r - l1i * h1i + d2[r]; h1i = l1r * h1i + l1i * h1r + d3[r]; h1r = t;
                    if (OUTPUT) { if (hi == owner) { const int s = 4 * run + i; hm[s * 68 + pc] = pk2(h0r, h0i); hm[s * 68 + pc + 32] = pk2(h1r, h1i); } }
                }
                h0r = xhalf(h0r, owner); h0i = xhalf(h0i, owner); h1r = xhalf(h1r, owner); h1i = xhalf(h1i, owner);
            }
            if (OUTPUT) {
                __syncthreads();
                bf16* Yd = dir ? Y1 : Y0;
#pragma unroll
                for (int st = 0; st < 2; ++st) {
                    f32x4 acc = {0.f, 0.f, 0.f, 0.f};
                    const int s = 16 * st + (lane & 15);
#pragma unroll
                    for (int kc = 0; kc < 4; ++kc) { const bf16x8 hb = *(const LAS bf16x8*)(hm + s * 68 + 16 * kc + 4 * (lane >> 4)); acc = MFMA16(cfr[kc], hb, acc); }
                    u32x2 w; w.x = pk2(acc[0], acc[1]); w.y = pk2(acc[2], acc[3]);
                    *(u32x2*)(Yd + (size_t)s5_row(b, dir, j0 + s) * D + g * 16 + 4 * (lane >> 4)) = w;
                }
                __syncthreads();
            }
        }
        if (!OUTPUT) {
            if (hi == 0) { float* e = EST + ebase + (size_t)sc * 64 * 128; e[pc * 2] = h0r; e[pc * 2 + 1] = h0i; e[(pc + 32) * 2] = h1r; e[(pc + 32) * 2 + 1] = h1i; }
        }
    }
}
__device__ __forceinline__ void s5_z_phase(Frame& F) {
    bf16* H = (bf16*)(F.ws + WS_H); const bf16* Y0 = (const bf16*)(F.ws + WS_U); const bf16* Y1 = (const bf16*)(F.ws + WS_U + ACT_BYTES);
    const float* dsk = INP(18);
    const size_t n8 = (size_t)MALL * D / 8;
    for (size_t i = (size_t)F.bid * NTHREADS + F.tid; i < n8; i += (size_t)F.G * NTHREADS) {
        const u32x4 h = *(const u32x4*)(H + i * 8), a = *(const u32x4*)(Y0 + i * 8), c = *(const u32x4*)(Y1 + i * 8);
        const int col = (int)((i * 8) & 1023);
        const f32x4 dA = *(const f32x4*)(dsk + col), dB = *(const f32x4*)(dsk + col + 4);
        const unsigned hh[4] = {h.x, h.y, h.z, h.w}, aa[4] = {a.x, a.y, a.z, a.w}, cc[4] = {c.x, c.y, c.z, c.w};
        unsigned o[4];
#pragma unroll
        for (int j = 0; j < 4; ++j) {
            const float dl = (j < 2) ? dA[2 * j] : dB[2 * j - 4], dh = (j < 2) ? dA[2 * j + 1] : dB[2 * j - 3];
            const float yl = dl * bflo(hh[j]) + bflo(aa[j]) + bflo(cc[j]), yh = dh * bfhi(hh[j]) + bfhi(aa[j]) + bfhi(cc[j]);
            const float zl = yl * fsigmoid(1.5957691216057308f * (yl + 0.044715f * yl * yl * yl)), zh = yh * fsigmoid(1.5957691216057308f * (yh + 0.044715f * yh * yh * yh));
            o[j] = pk2(zl, zh);
        }
        *(u32x4*)(H + i * 8) = (u32x4){o[0], o[1], o[2], o[3]};
    }
}

template <int NDB>
__device__ __forceinline__ void flash_pv(const LAS unsigned char* vs, int r32, int hi, const bf16x8 (&pw)[4], f32x16 (&o)[NDB]) {
    const LAS unsigned char* vrow = vs + r32 * 144 + hi * 16;
#pragma unroll
    for (int d2 = 0; d2 < NDB; d2 += 2) {
        bf16x8 vf[2][4];
#pragma unroll
        for (int db = 0; db < 2; ++db)
#pragma unroll
            for (int q = 0; q < 4; ++q) vf[db][q] = *(const LAS bf16x8*)(vrow + (d2 + db) * 32 * 144 + q * 32);
        __builtin_amdgcn_sched_barrier(0);
#pragma unroll
        for (int q = 0; q < 4; ++q)
#pragma unroll
            for (int db = 0; db < 2; ++db) o[d2 + db] = MFMA32(vf[db][q], pw[q], o[d2 + db]);
        __builtin_amdgcn_sched_barrier(0);
    }
}
template <int DV, bool NA>
__device__ __forceinline__ void flash_pass(Frame& F, const bf16* Qw  , const bf16* Kb, const bf16* Vtb, int ta1, int tb0, int tb1,
                                           int rq, int qc, f32x16 (&o)[DV / 32]) {
    constexpr bool na = NA;
    constexpr int NDB = DV / 32, KS_B = 64 * 72 * 2, VS_B = DV * 72 * 2, VOFF = 2 * KS_B, BOFF = VOFF + 3 * VS_B;
    constexpr int NVL = DV / 64;
    const int tid = F.tid, lane = F.lane, r32 = lane & 31, hi = lane >> 5;
    const bool grpB = (F.wave & 1);
    const LAS float* bias = (const LAS float*)(F.lds + BOFF);
    bf16x8 qr[4];
#pragma unroll
    for (int d0 = 0; d0 < 4; ++d0) qr[d0] = *(const bf16x8*)(Qw + (size_t)r32 * 64 + d0 * 16 + hi * 8);
#pragma unroll
    for (int db = 0; db < NDB; ++db) o[db] = (f32x16){};
    float mrun = -3.0e38f, lrun = 0.f;
    const int nt = ta1 + (tb1 - tb0);
    const int krow = tid >> 3, kch = tid & 7;
    u32x4 kregA, kregB; u32x4 vregA[NVL], vregB[NVL];
    bf16x8 pw[4]; bool havePV = false; int pvb = 0;
#define FL_VDST(vbuf, idx) (F.lds + VOFF + (vbuf) * VS_B + ((idx) >> 3) * 144 + (((idx) & 7) >> 1) * 32 + ((idx) & 1) * 8)
#define FL_TILE(i) (((i) < ta1) ? (i) : tb0 + ((i) - ta1))
#define FL_LOAD(KR, VR, i) do { const int tl_ = FL_TILE(i); KR = *(const u32x4*)(Kb + ((size_t)tl_ * 64 + krow) * 64 + kch * 8); \
        _Pragma("unroll") for (int i_ = 0; i_ < NVL; ++i_) { const int idx = tid + 512 * i_; VR[i_] = *(const u32x4*)(Vtb + (size_t)(idx >> 3) * TALL + tl_ * 64 + (idx & 7) * 8); } } while (0)
#define FL_STORE(KR, VR, kbuf, vbuf) do { *(LAS u32x4*)(F.lds + (kbuf) * KS_B + krow * 144 + kch * 16) = KR; \
        _Pragma("unroll") for (int i_ = 0; i_ < NVL; ++i_) { const int idx = tid + 512 * i_; LAS unsigned char* p = FL_VDST(vbuf, idx); *(LAS u32x2*)p = (u32x2){VR[i_].x, VR[i_].y}; *(LAS u32x2*)(p + 16) = (u32x2){VR[i_].z, VR[i_].w}; } } while (0)
    FL_LOAD(kregA, vregA, 0); FL_STORE(kregA, vregA, 0, 0);
    if (1 < nt) FL_LOAD(kregA, vregA, 1);
    if (2 < nt) FL_LOAD(kregB, vregB, 2);
    __syncthreads();
    int vb = 0;
    auto step = [&](const int it, u32x4& kregX, u32x4 (&vregX)[NVL]) {
        const int buf = it & 1;
        const int tile = FL_TILE(it);
        const bool more = (it + 1 < nt);
        if (havePV) { flash_pv<NDB>(F.lds + VOFF + pvb * VS_B, r32, hi, pw, o); havePV = false; }
        bool active = true; int kr = 0;
        if (na && tile >= 4) { kr = tile - 4; int r0 = rq - 4; r0 = r0 < 0 ? 0 : (r0 > 56 ? 56 : r0); active = (kr >= r0) && (kr < r0 + 8); }
        if (active) {
            const LAS unsigned char* ks = F.lds + buf * KS_B;
            f32x16 p0 = {}, p1 = {};
            {
                bf16x8 kf[8];
#pragma unroll
                for (int d0 = 0; d0 < 4; ++d0) { kf[2 * d0] = *(const LAS bf16x8*)(ks + r32 * 144 + d0 * 32 + hi * 16); kf[2 * d0 + 1] = *(const LAS bf16x8*)(ks + (32 + r32) * 144 + d0 * 32 + hi * 16); }
                __builtin_amdgcn_sched_barrier(0);
#pragma unroll
                for (int d0 = 0; d0 < 4; ++d0) { p0 = MFMA32(kf[2 * d0], qr[d0], p0); p1 = MFMA32(kf[2 * d0 + 1], qr[d0], p1); }
            }
            if (na && tile >= 4) {
                int c0 = qc - 8; c0 = c0 < 0 ? 0 : (c0 > 48 ? 48 : c0);
                const int brow = (kr - rq + 7) * 31 + 15 - qc;
#pragma unroll
                for (int r = 0; r < 16; ++r) {
                    const int kc0 = crow(r, hi), kc1 = 32 + kc0;
                    const bool v0 = (kc0 >= c0) && (kc0 < c0 + 16), v1 = (kc1 >= c0) && (kc1 < c0 + 16);
                    p0[r] = v0 ? p0[r] + bias[brow + kc0] : -1.0e30f;
                    p1[r] = v1 ? p1[r] + bias[brow + kc1] : -1.0e30f;
                }
            }
            float mx;
            { float t[16];
#pragma unroll
              for (int r = 0; r < 16; ++r) t[r] = fmaxf(p0[r], p1[r]);
#pragma unroll
              for (int w_ = 8; w_ >= 1; w_ >>= 1)
#pragma unroll
                  for (int r = 0; r < w_; ++r) t[r] = fmaxf(t[r], t[r + w_]);
              mx = t[0]; }
            mx = fmaxf(mx, __shfl_xor(mx, 32));
            if (__any(mx > mrun + 8.0f)) {
                const float mnew = fmaxf(mrun, mx);
                const float alpha = __builtin_amdgcn_exp2f(mrun - mnew);
                mrun = mnew; lrun *= alpha;
#pragma unroll
                for (int db = 0; db < NDB; ++db)
#pragma unroll
                    for (int r = 0; r < 16; ++r) o[db][r] *= alpha;
            }
            { float t[16];
#pragma unroll
              for (int r = 0; r < 16; ++r) { p0[r] = __builtin_amdgcn_exp2f(p0[r] - mrun); p1[r] = __builtin_amdgcn_exp2f(p1[r] - mrun); t[r] = p0[r] + p1[r]; }
#pragma unroll
              for (int w_ = 8; w_ >= 1; w_ >>= 1)
#pragma unroll
                  for (int r = 0; r < w_; ++r) t[r] += t[r + w_];
              lrun += t[0]; }
#pragma unroll
            for (int q = 0; q < 4; ++q) {
                u32x4 w;
                if (q < 2) { w.x = pk2(p0[8 * q + 0], p0[8 * q + 1]); w.y = pk2(p0[8 * q + 2], p0[8 * q + 3]); w.z = pk2(p0[8 * q + 4], p0[8 * q + 5]); w.w = pk2(p0[8 * q + 6], p0[8 * q + 7]); }
                else { const int qq = q - 2; w.x = pk2(p1[8 * qq + 0], p1[8 * qq + 1]); w.y = pk2(p1[8 * qq + 2], p1[8 * qq + 3]); w.z = pk2(p1[8 * qq + 4], p1[8 * qq + 5]); w.w = pk2(p1[8 * qq + 6], p1[8 * qq + 7]); }
                pw[q] = __builtin_bit_cast(bf16x8, w);
            }
            if (grpB) { havePV = true; pvb = vb; }
            else flash_pv<NDB>(F.lds + VOFF + vb * VS_B, r32, hi, pw, o);
        }
        const int vnext = (vb == 2) ? 0 : vb + 1;
        if (more) {
            FL_STORE(kregX, vregX, buf ^ 1, vnext);
            if (it + 3 < nt) FL_LOAD(kregX, vregX, it + 3);
        }
        vb = vnext;
        __syncthreads();
    };
    for (int it = 0; it < nt; it += 2) {
        step(it, kregA, vregA);
        if (it + 1 < nt) step(it + 1, kregB, vregB);
    }
    if (havePV) flash_pv<NDB>(F.lds + VOFF + pvb * VS_B, r32, hi, pw, o);
    __syncthreads();
#undef FL_VDST
#undef FL_TILE
#undef FL_LOAD
#undef FL_STORE
    lrun += __shfl_xor(lrun, 32);
    const float rl = 1.0f / lrun;
#pragma unroll
    for (int db = 0; db < NDB; ++db)
#pragma unroll
        for (int r = 0; r < 16; ++r) o[db][r] *= rl;
}

__device__ __forceinline__ void att_da_phase(Frame& F) {
    const bf16* Q = (const bf16*)(F.ws + WS_U); const bf16* K = (const bf16*)(F.ws + WS_U + ACT_BYTES); const bf16* Vt = (const bf16*)(F.ws + WS_U + 2 * ACT_BYTES);
    bf16* OA = (bf16*)(F.ws + WS_H);
    float* stash = (float*)(F.ws + WS_E) + (size_t)F.bid * (8 * 64 * 64) + F.wave * (64 * 64);
    float s1 = 0.f, s2 = 0.f;
    for (int i = 0; i < 64; ++i) { s1 += INP(23)[i] * INP(24)[i]; s2 += INP(25)[i] * INP(26)[i]; }
    const float lam_init = 0.8f - 0.6f * expf(-0.3f * 1.0f);
    const float lam = expf(s1) - expf(s2) + lam_init;
    const int lane = F.lane, r32 = lane & 31, hi = lane >> 5;
    const int vcu = (F.G % 8 == 0) ? (F.bid % 8) * (F.G / 8) + F.bid / 8 : F.bid;
    for (int u = vcu; u < 8 * 8 * 17; u += F.G) {
        int b, h, qb;
        if (u < 1024) { b = u >> 7; h = (u >> 4) & 7; qb = 1 + (u & 15); } else { const int v = u - 1024; b = v >> 3; h = v & 7; qb = 0; }
        const int s0 = 256 * qb + 32 * F.wave;
        const int nta = qb ? 68 : 4;
        f32x16 o[4];
#pragma unroll 1
        for (int m = 0; m < 2; ++m) {
            const int hm = 2 * h + m;
            flash_pass<128, false>(F, Q + ((size_t)(b * 16 + hm) * TALL + s0) * 64, K + (size_t)(b * 16 + hm) * TALL * 64, Vt + (size_t)(b * 8 + h) * 128 * TALL, nta, 0, 0, 0, 0, o);
            if (m == 0) {
                GAS float* sp = (GAS float*)(stash + lane); asm volatile("" : "+v"(sp));
#pragma unroll
                for (int db = 0; db < 4; ++db)
#pragma unroll
                    for (int r = 0; r < 16; ++r) sp[(db * 16 + r) * 64] = o[db][r];
            }
        }
        float ss = 0.f;
        {
            const GAS float* sp = (const GAS float*)(stash + lane); asm volatile("" : "+v"(sp));
#pragma unroll
            for (int db = 0; db < 4; ++db) {
#pragma unroll
                for (int r = 0; r < 16; ++r) { const float a = sp[(db * 16 + r) * 64] - lam * o[db][r]; o[db][r] = a; ss += a * a; }
                asm volatile("" ::: "memory");
            }
        }
        ss += __shfl_xor(ss, 32);
        const float rstd = rsqrtf(ss * (1.0f / 128.0f) + RMS_EPS) * (1.0f - lam_init);
        const int s = s0 + r32;
        const size_t row = qb ? (size_t)b * 4096 + (s - 256) : (size_t)MLAT + b * 256 + s;
        GAS bf16* op = (GAS bf16*)(OA + row * D + h * 128 + 4 * hi); asm volatile("" : "+v"(op));
        const GAS float* gp = (const GAS float*)(INP(27) + 4 * hi); asm volatile("" : "+v"(gp));
#pragma unroll
        for (int db = 0; db < 4; ++db)
#pragma unroll
            for (int rg = 0; rg < 4; ++rg) {
                const int d = 32 * db + 8 * rg;
                const f32x4 g = *(const GAS f32x4*)(gp + d);
                u32x2 w; w.x = pk2(o[db][4 * rg] * rstd * g[0], o[db][4 * rg + 1] * rstd * g[1]); w.y = pk2(o[db][4 * rg + 2] * rstd * g[2], o[db][4 * rg + 3] * rstd * g[3]);
                *(GAS u32x2*)(op + d) = w;
            }
    }
}
__device__ __forceinline__ void att_na_phase(Frame& F) {
    const bf16* Q = (const bf16*)(F.ws + WS_U); const bf16* K = (const bf16*)(F.ws + WS_U + ACT_BYTES); const bf16* Vt = (const bf16*)(F.ws + WS_U + 2 * ACT_BYTES);
    bf16* OA = (bf16*)(F.ws + WS_H);
    constexpr int BOFF = 2 * 64 * 72 * 2 + 3 * 64 * 72 * 2;
    LAS float* bias = (LAS float*)(F.lds + BOFF);
    const int lane = F.lane, r32 = lane & 31, hi = lane >> 5;
    const int vcu = (F.G % 8 == 0) ? (F.bid % 8) * (F.G / 8) + F.bid / 8 : F.bid;
    for (int u = vcu; u < 8 * 16 * 17; u += F.G) {
        int b, h, R4; bool lat;
        if (u < 2048) { b = u >> 8; h = (u >> 4) & 15; R4 = u & 15; lat = true; } else { const int v = u - 2048; b = v >> 4; h = v & 15; R4 = 0; lat = false; }
        if (lat) { for (int i = F.tid; i < 15 * 31; i += NTHREADS) bias[i] = INP(30)[h * 465 + i] * LOG2E; }
        const int s0 = (lat ? 256 + 256 * R4 : 0) + 32 * F.wave;
        int lo = 4 * R4 - 4; lo = lo < 0 ? 0 : (lo > 56 ? 56 : lo);
        int hh = 4 * R4 + 3 - 4; hh = hh < 0 ? 0 : (hh > 56 ? 56 : hh); hh += 8;
        f32x16 o[2];
        if (lat) flash_pass<64, true>(F, Q + ((size_t)(b * 16 + h) * TALL + s0) * 64, K + (size_t)(b * 16 + h) * TALL * 64, Vt + (size_t)(b * 16 + h) * 64 * TALL, 4, 4 + lo, 4 + hh, 4 * R4 + (F.wave >> 1), 32 * (F.wave & 1) + r32, o);
        else flash_pass<64, false>(F, Q + ((size_t)(b * 16 + h) * TALL + s0) * 64, K + (size_t)(b * 16 + h) * TALL * 64, Vt + (size_t)(b * 16 + h) * 64 * TALL, 4, 0, 0, 0, 0, o);
        const int s = s0 + r32;
        const size_t row = lat ? (size_t)b * 4096 + (s - 256) : (size_t)MLAT + b * 256 + s;
        GAS bf16* op = (GAS bf16*)(OA + row * D + h * 64 + 4 * hi); asm volatile("" : "+v"(op));
#pragma unroll
        for (int db = 0; db < 2; ++db)
#pragma unroll
            for (int rg = 0; rg < 4; ++rg) {
                const int d = 32 * db + 8 * rg;
                u32x2 w; w.x = pk2(o[db][4 * rg], o[db][4 * rg + 1]); w.y = pk2(o[db][4 * rg + 2], o[db][4 * rg + 3]);
                *(GAS u32x2*)(op + d) = w;
            }
    }
}

__device__ __forceinline__ bf16* hg_o1_row(Frame& F, int row) {
    return (bf16*)(F.ws + WS_U + 4 * ACT_BYTES) + (size_t)row * D;
}
__device__ __forceinline__ void gla_phase(Frame& F) {
    const bf16* Qb = (const bf16*)(F.ws + WS_U); const bf16* Ib = (const bf16*)(F.ws + WS_U + ACT_BYTES);
    const bf16* Z0 = (const bf16*)F.out; const bf16* Z1 = (const bf16*)(F.ws + WS_U + 3 * ACT_BYTES);
    bf16* O0 = (bf16*)(F.ws + WS_H);
    constexpr int QD = 0, KI = 17408, KDT = 34816, VT = 53248, ST = 62464, ATT = 79872, GL = 89088, TOT = 89600;
    constexpr int ZS = 91648, QS = ZS + 17408, VS2 = QS + 17408;
    const int tid = F.tid, lane = F.lane, w = F.wave, r32 = lane & 31, hi = lane >> 5;
    const int kcol = tid & 127, tq = tid >> 7, vcol = tid & 63, tv = tid >> 6;
    for (int u = F.bid; u < 256; u += F.G) {
        const int b = u >> 5, h = (u >> 2) & 7, dir = (u >> 1) & 1, vh = u & 1;
        const bf16* Zd = dir ? Z1 : Z0;
        float lbk;
        { const int c = h * 128 + kcol; const float a0 = INP(34)[c], a1 = INP(34)[1024 + c], a2 = INP(34)[2048 + c], a3 = INP(34)[3072 + c];
          const float mx = fmaxf(fmaxf(a0, a1), fmaxf(a2, a3)); const float e0 = expf(a0 - mx), e1 = expf(a1 - mx), e2 = expf(a2 - mx), e3 = expf(a3 - mx);
          lbk = (e1 + e2 + e3) / (e0 + e1 + e2 + e3); }
        const float omlb = 1.0f - lbk;
        f32x16 S = {};
        for (int i = tid; i < 17408 / 4; i += NTHREADS) ((LAS unsigned*)(F.lds + ST))[i] = 0u;
        const int kb = w >> 1, vb = w & 1;
        u32x4 zreg[2], qreg[2], vreg;
        const int sj0 = tid >> 4, sc0 = (tid & 15) * 8;
        const int vj = tid >> 3, vc = (tid & 7) * 8;
#define GLA_ROW(c, j) ((c) < 4 ? (MLAT + b * 256 + (dir ? 255 - (64 * (c) + (j)) : 64 * (c) + (j))) : (b * 4096 + (dir ? 4095 - (64 * ((c) - 4) + (j)) : 64 * ((c) - 4) + (j))))
#define GLA_LOAD(c) do { _Pragma("unroll") for (int i = 0; i < 2; ++i) { const size_t ro = (size_t)GLA_ROW(c, sj0 + 32 * i) * D + h * 128 + sc0; zreg[i] = *(const u32x4*)(Zd + ro); qreg[i] = *(const u32x4*)(Qb + ro); } \
        vreg = *(const u32x4*)(Ib + (size_t)GLA_ROW(c, vj) * D + h * 128 + vh * 64 + vc); } while (0)
#define GLA_PARK() do { _Pragma("unroll") for (int i = 0; i < 2; ++i) { *(LAS u32x4*)(F.lds + ZS + (sj0 + 32 * i) * 272 + sc0 * 2) = zreg[i]; *(LAS u32x4*)(F.lds + QS + (sj0 + 32 * i) * 272 + sc0 * 2) = qreg[i]; } \
        *(LAS u32x4*)(F.lds + VS2 + vj * 144 + vc * 2) = vreg; } while (0)
        GLA_LOAD(0); GLA_PARK(); GLA_LOAD(1);
        __syncthreads();
        for (int c = 0; c < 68; ++c) {
            float g[16], kk[16], run = 0.f;
#pragma unroll
            for (int i = 0; i < 16; ++i) { const float sg = fsigmoid(bf2f(((const LAS bf16*)(F.lds + ZS))[(16 * tq + i) * 136 + kcol])); const float f = lbk + omlb * sg; run += __logf(f); g[i] = run; kk[i] = omlb * (1.0f - sg); }
            ((LAS float*)(F.lds + TOT))[tq * 128 + kcol] = run;
            __syncthreads();
            float pre = 0.f, gl = 0.f;
#pragma unroll
            for (int q = 0; q < 4; ++q) { const float t = ((LAS float*)(F.lds + TOT))[q * 128 + kcol]; gl += t; if (q < tq) pre += t; }
            const float egl = fexp(gl);
            unsigned kdp[8];
#pragma unroll
            for (int i = 0; i < 16; i += 2) {
                const float g0 = g[i] + pre, g1 = g[i + 1] + pre;
                const float e0 = fexp(g0), e1 = fexp(g1);
                const float ie0 = __builtin_amdgcn_rcpf(e0), ie1 = __builtin_amdgcn_rcpf(e1);
                const int j0 = 16 * tq + i;
                const float q0 = bf2f(((const LAS bf16*)(F.lds + QS))[j0 * 136 + kcol]), q1 = bf2f(((const LAS bf16*)(F.lds + QS))[(j0 + 1) * 136 + kcol]);
                ((LAS bf16*)(F.lds + QD))[j0 * 136 + kcol] = (bf16)f2bf(q0 * e0); ((LAS bf16*)(F.lds + QD))[(j0 + 1) * 136 + kcol] = (bf16)f2bf(q1 * e1);
                ((LAS bf16*)(F.lds + KI))[j0 * 136 + kcol] = (bf16)f2bf(kk[i] * ie0); ((LAS bf16*)(F.lds + KI))[(j0 + 1) * 136 + kcol] = (bf16)f2bf(kk[i + 1] * ie1);
                kdp[i >> 1] = pk2(kk[i] * egl * ie0, kk[i + 1] * egl * ie1);
            }
            { LAS u32x4* p = (LAS u32x4*)(F.lds + KDT + kcol * 144 + tq * 32); p[0] = (u32x4){kdp[0], kdp[1], kdp[2], kdp[3]}; p[1] = (u32x4){kdp[4], kdp[5], kdp[6], kdp[7]}; }
            if (tq == 0) ((LAS float*)(F.lds + GL))[kcol] = egl;
            { unsigned short vr[8];
#pragma unroll
              for (int i = 0; i < 8; ++i) vr[i] = ((const LAS bf16*)(F.lds + VS2))[(8 * tv + i) * 72 + vcol];
              LAS u32x4* p = (LAS u32x4*)(F.lds + VT + vcol * 144 + tv * 16);
              p[0] = (u32x4){(unsigned)vr[0] | ((unsigned)vr[1] << 16), (unsigned)vr[2] | ((unsigned)vr[3] << 16), (unsigned)vr[4] | ((unsigned)vr[5] << 16), (unsigned)vr[6] | ((unsigned)vr[7] << 16)}; }
            __syncthreads();
            f32x16 oacc = {};
            const int tb = (w - 4) >> 1, ovb = (w - 4) & 1;
            if (c >= 4) {
                if (w < 3) {
                    const int atb = (w >= 1), asb = (w == 2);
                    f32x16 a = {};
#pragma unroll
                    for (int q = 0; q < 8; ++q) {
                        const bf16x8 fa = *(const LAS bf16x8*)(F.lds + QD + (32 * atb + r32) * 272 + q * 32 + hi * 16);
                        const bf16x8 fb = *(const LAS bf16x8*)(F.lds + KI + (32 * asb + r32) * 272 + q * 32 + hi * 16);
                        a = MFMA32(fa, fb, a);
                    }
                    const int sg = 32 * asb + r32;
#pragma unroll
                    for (int r = 0; r < 16; ++r) { const int t = 32 * atb + crow(r, hi); ((LAS bf16*)(F.lds + ATT))[t * 72 + sg] = (bf16)f2bf(sg <= t ? a[r] : 0.f); }
                } else if (w >= 4) {
#pragma unroll
                    for (int q = 0; q < 8; ++q) {
                        const bf16x8 fa = *(const LAS bf16x8*)(F.lds + QD + (32 * tb + r32) * 272 + q * 32 + hi * 16);
                        const bf16x8 fb = *(const LAS bf16x8*)(F.lds + ST + (32 * ovb + r32) * 272 + q * 32 + hi * 16);
                        oacc = MFMA32(fa, fb, oacc);
                    }
                }
            }
            __syncthreads();
            if (c >= 4 && w >= 4) {
                const int nss = tb ? 4 : 2;
                for (int q = 0; q < nss; ++q) {
                    const bf16x8 fa = *(const LAS bf16x8*)(F.lds + ATT + (32 * tb + r32) * 144 + q * 32 + hi * 16);
                    const bf16x8 fb = *(const LAS bf16x8*)(F.lds + VT + (32 * ovb + r32) * 144 + q * 32 + hi * 16);
                    oacc = MFMA32(fa, fb, oacc);
                }
#pragma unroll
                for (int r = 0; r < 16; ++r) { const int row = GLA_ROW(c, 32 * tb + crow(r, hi));
                    bf16* dst = (dir ? hg_o1_row(F, row) : O0 + (size_t)row * D) + h * 128 + vh * 64 + 32 * ovb + r32;
                    *dst = (bf16)f2bf(oacc[r]); }
            }
            {
                f32x16 ds = {};
#pragma unroll
                for (int q = 0; q < 4; ++q) {
                    const bf16x8 fa = *(const LAS bf16x8*)(F.lds + KDT + (32 * kb + r32) * 144 + q * 32 + hi * 16);
                    const bf16x8 fb = *(const LAS bf16x8*)(F.lds + VT + (32 * vb + r32) * 144 + q * 32 + hi * 16);
                    ds = MFMA32(fa, fb, ds);
                }
#pragma unroll
                for (int r = 0; r < 16; ++r) S[r] = ((LAS float*)(F.lds + GL))[32 * kb + crow(r, hi)] * S[r] + ds[r];
#pragma unroll
                for (int rg = 0; rg < 4; ++rg) { u32x2 wv; wv.x = pk2(S[4 * rg], S[4 * rg + 1]); wv.y = pk2(S[4 * rg + 2], S[4 * rg + 3]);
                    *(LAS u32x2*)(F.lds + ST + (32 * vb + r32) * 272 + (32 * kb + 8 * rg + 4 * hi) * 2) = wv; }
            }
            if (c + 1 < 68) { GLA_PARK(); if (c + 2 < 68) GLA_LOAD(c + 2); }
            __syncthreads();
        }
#undef GLA_LOAD
#undef GLA_PARK
#undef GLA_ROW
    }
}
__device__ __forceinline__ void hg_readout_phase(Frame& F) {
    const bf16* O0 = (const bf16*)(F.ws + WS_H); const bf16* Gt = (const bf16*)(F.ws + WS_U + 2 * ACT_BYTES);
    bf16* Hout = (bf16*)(F.ws + WS_H);
    const int gw = F.bid * NWAVES + F.wave, NGW = F.G * NWAVES;
    const int c0 = 16 * F.lane;
    for (int row = gw; row < MLAT; row += NGW) {
        const u32x4 a0 = *(const u32x4*)(O0 + (size_t)row * D + c0), a1 = *(const u32x4*)(O0 + (size_t)row * D + c0 + 8);
        const bf16* o1p = hg_o1_row(F, row) + c0;
        const u32x4 b0 = *(const u32x4*)o1p, b1 = *(const u32x4*)(o1p + 8);
        const u32x4 g0 = *(const u32x4*)(Gt + (size_t)row * D + c0), g1 = *(const u32x4*)(Gt + (size_t)row * D + c0 + 8);
        const unsigned aa[8] = {a0.x, a0.y, a0.z, a0.w, a1.x, a1.y, a1.z, a1.w}, bb[8] = {b0.x, b0.y, b0.z, b0.w, b1.x, b1.y, b1.z, b1.w}, gg[8] = {g0.x, g0.y, g0.z, g0.w, g1.x, g1.y, g1.z, g1.w};
        float v[16]; float ss = 0.f;
#pragma unroll
        for (int j = 0; j < 8; ++j) { v[2 * j] = bflo(aa[j]) + bflo(bb[j]); v[2 * j + 1] = bfhi(aa[j]) + bfhi(bb[j]); ss += v[2 * j] * v[2 * j] + v[2 * j + 1] * v[2 * j + 1]; }
        ss += __shfl_xor(ss, 1); ss += __shfl_xor(ss, 2); ss += __shfl_xor(ss, 4);
        const float rstd = rsqrtf(ss * (1.0f / 128.0f) + RMS_EPS);
        unsigned o[8];
#pragma unroll
        for (int j = 0; j < 8; ++j) {
            const float gl = bflo(gg[j]), gh = bfhi(gg[j]);
            const float n0 = INP(35)[(c0 + 2 * j) & 127], n1 = INP(35)[(c0 + 2 * j + 1) & 127];
            o[j] = pk2(v[2 * j] * rstd * n0 * gl * fsigmoid(gl), v[2 * j + 1] * rstd * n1 * gh * fsigmoid(gh));
        }
        *(u32x4*)(Hout + (size_t)row * D + c0) = (u32x4){o[0], o[1], o[2], o[3]};
        *(u32x4*)(Hout + (size_t)row * D + c0 + 8) = (u32x4){o[4], o[5], o[6], o[7]};
    }
}

#define XB_TMO      128
#define XB_XCNT(j)  (256  + 64 * (j))
#define XB_XSUB(j)  (1280 + 64 * (j))
#define XB_XGEN(j)  (2304 + 64 * (j))
#define XB_TOP      3328
#define XB_TOPGEN   3392
#define XCD_BAR_WORDS 3456
#define XB_SPIN_CAP (1u << 18)

__device__ __forceinline__ unsigned xb_ld(unsigned* p)              { return __hip_atomic_load(p, __ATOMIC_RELAXED, __HIP_MEMORY_SCOPE_AGENT); }
__device__ __forceinline__ unsigned xb_add(unsigned* p, unsigned v) { return __hip_atomic_fetch_add(p, v, __ATOMIC_RELAXED, __HIP_MEMORY_SCOPE_AGENT); }
__device__ __forceinline__ unsigned xb_xcc_id() { return (unsigned)__builtin_amdgcn_s_getreg((3 << 11) | 20) & 0xFu; }
#define XB_SPIN(cond, bar) do { unsigned _sp = 0; while (cond) { __builtin_amdgcn_s_sleep(1); \
    if ((++_sp & 255u) == 0u) { if (xb_ld(&(bar)[XB_TMO])) break; if (_sp > XB_SPIN_CAP) { atomicAdd(&(bar)[XB_TMO], 1u); break; } } } } while (0)

struct XcdBarrier {
    unsigned* bar; unsigned x;
    volatile LAS unsigned* st;
};

__device__ __forceinline__ XcdBarrier xcd_barrier_post(unsigned* bar, volatile LAS unsigned* st) {
    XcdBarrier b; b.bar = bar; b.x = xb_xcc_id(); b.st = st;
    if (threadIdx.x == 0) (void)xb_add(&bar[XB_XCNT(b.x)], 1u);
    return b;
}
__device__ __forceinline__ void xcd_barrier_complete(unsigned* bar, unsigned x, unsigned& nloc, unsigned& nx) {
    const unsigned G = gridDim.x * gridDim.y * gridDim.z;
    unsigned sum, cnt, mine, sp = 0u;
    for (;;) {
        sum = 0u; cnt = 0u; mine = 0u;
#pragma unroll
        for (unsigned j = 0; j < 16; ++j) { const unsigned c = xb_ld(&bar[XB_XCNT(j)]); sum += c; cnt += (c > 0u) ? 1u : 0u; mine = (j == x) ? c : mine; }
        if (sum == G) break;
        __builtin_amdgcn_s_sleep(1);
        if ((++sp & 255u) == 0u) { if (xb_ld(&bar[XB_TMO])) break; if (sp > XB_SPIN_CAP) { atomicAdd(&bar[XB_TMO], 1u); break; } }
    }
    nloc = mine > 0u ? mine : 1u; nx = cnt > 0u ? cnt : 1u;
}

__device__ __forceinline__ void xcd_barrier(const XcdBarrier& b) {
    asm volatile("s_waitcnt vmcnt(0)" ::: "memory");
    __syncthreads();
    if (threadIdx.x == 0) {
        unsigned* bar = b.bar;
        __builtin_amdgcn_s_waitcnt(0);
        unsigned nloc = b.st[0], nx = b.st[1];
        if (nloc == 0u) { xcd_barrier_complete(bar, b.x, nloc, nx); b.st[0] = nloc; b.st[1] = nx; }
        const unsigned old = xb_add(&bar[XB_XSUB(b.x)], 1u);
        const unsigned gen = old / nloc;
        if (old + 1u == (gen + 1u) * nloc) {
            __builtin_amdgcn_fence(__ATOMIC_RELEASE, "agent");
            asm volatile("s_waitcnt vmcnt(0)" ::: "memory");
            const unsigned og = xb_add(&bar[XB_TOP], 1u);
            const unsigned tg = og / nx;
            if (og + 1u == (tg + 1u) * nx) xb_add(&bar[XB_TOPGEN], 1u);
            else XB_SPIN(xb_ld(&bar[XB_TOPGEN]) == tg, bar);
            __builtin_amdgcn_fence(__ATOMIC_ACQUIRE, "agent");
            xb_add(&bar[XB_XGEN(b.x)], 1u);
            asm volatile("s_waitcnt vmcnt(0)" ::: "memory");
        } else {
            XB_SPIN(xb_ld(&bar[XB_XGEN(b.x)]) == gen, bar);
            __builtin_amdgcn_fence(__ATOMIC_ACQUIRE, "agent");
            asm volatile("s_waitcnt vmcnt(0)" ::: "memory");
        }
    }
    __syncthreads();
}

#ifndef PHASE_MASK
#define PHASE_MASK 0xffff
#endif
#define PH_ON(op) (((PHASE_MASK) >> (op)) & 1)
enum { OP_NOP = 0, OP_SWIGLU, OP_BF16, OP_NORM, OP_S5A, OP_S5B, OP_S5Z, OP_GLU, OP_QKV_DA, OP_QKV_NA, OP_ATT_DA, OP_ATT_NA, OP_GLA, OP_READOUT };
#define ST(op, sub) ((op) | ((sub) << 4))
#define NOSYNC 256
__device__ const int PROGRAM[4][12] = {
    {ST(OP_SWIGLU, 0), ST(OP_BF16, 0), ST(OP_NORM, 0), ST(OP_S5A, 0), ST(OP_S5B, 0), ST(OP_S5Z, 0), ST(OP_GLU, 0), OP_NOP, ST(OP_NORM, 1), ST(OP_SWIGLU, 1), ST(OP_BF16, 1), ST(OP_NORM, 2)},
    {ST(OP_SWIGLU, 0), ST(OP_BF16, 0), ST(OP_NORM, 0), ST(OP_QKV_DA, 0), ST(OP_ATT_DA, 0), ST(OP_BF16, 2), OP_NOP, OP_NOP, ST(OP_NORM, 1), ST(OP_SWIGLU, 1), ST(OP_BF16, 1), ST(OP_NORM, 2)},
    {ST(OP_SWIGLU, 0), ST(OP_BF16, 0), ST(OP_NORM, 0), ST(OP_QKV_NA, 0), ST(OP_ATT_NA, 0), ST(OP_BF16, 2), OP_NOP, OP_NOP, ST(OP_NORM, 1), ST(OP_SWIGLU, 1), ST(OP_BF16, 1), ST(OP_NORM, 2)},
    {ST(OP_SWIGLU, 0), ST(OP_BF16, 0), ST(OP_NORM, 0), ST(OP_BF16, 3), OP_NOP, ST(OP_GLA, 0), ST(OP_READOUT, 0), ST(OP_BF16, 5), ST(OP_NORM, 1), ST(OP_SWIGLU, 1), ST(OP_BF16, 1), ST(OP_NORM, 2)},
};

#define GSYNC_CG() do { asm volatile("s_waitcnt vmcnt(0) lgkmcnt(0)" ::: "memory"); grid.sync(); __builtin_amdgcn_fence(__ATOMIC_ACQUIRE, "agent"); asm volatile("s_waitcnt vmcnt(0)" ::: "memory"); } while (0)
#define GSYNC() do { XcdBarrier xb_; xb_.bar = (unsigned*)(F.ws + WS_BAR); xb_.x = xb_xcc_id(); xb_.st = (volatile LAS unsigned*)(F.lds + LDS_BYTES - 1024); xcd_barrier(xb_); } while (0)
__global__ void __launch_bounds__(NTHREADS, 2) mega_fwd(Args args) {
    extern __shared__ __attribute__((aligned(16))) unsigned char lds_raw[];
    cg::grid_group grid = cg::this_grid();
    Frame F;
    F.lds = (LAS unsigned char*)lds_raw;
    F.tid = threadIdx.x; F.lane = F.tid & 63; F.wave = __builtin_amdgcn_readfirstlane(F.tid >> 6); F.G = gridDim.x; F.bid = blockIdx.x;
    F.ptab = (LAS unsigned long long*)(F.lds + LDS_BYTES - 512);
#pragma unroll
    for (int i = 0; i < 37; ++i) { if (F.tid == i) F.ptab[i] = (unsigned long long)args.in[i]; }
    F.out = (GAS float*)args.out; F.ws = (GAS unsigned char*)args.ws;
    __syncthreads();

    if (F.tid < 2) ((volatile LAS unsigned*)(F.lds + LDS_BYTES - 1024))[F.tid] = 0u;
    __syncthreads();
    (void)xcd_barrier_post((unsigned*)(F.ws + WS_BAR), (volatile LAS unsigned*)(F.lds + LDS_BYTES - 1024));
#ifdef PROBE_P0
    phase_p0(F);
    GSYNC_CG();
#endif
    phase_p0(F);
    GSYNC_CG();
    norm_phase(F, MALL, true, nullptr, nullptr, 0.f, 0, 0, INP(6), 0, 0, false);
    GSYNC();
#ifdef PROBE_SYNCS
#pragma unroll 1
    for (int i = 0; i < PROBE_SYNCS; ++i) GSYNC();
#endif

#pragma unroll 1
    for (int li = 0; li < 4; ++li) {
#pragma unroll 1
        for (int st = 0; st < 12; ++st) {
            const int code = PROGRAM[li][st]; const int op = code & 15, sub = (code >> 4) & 15;
            if (op == OP_NOP) continue;
            const int Mrows = (li == 3 && st >= 7) ? MLAT : MALL;
#ifdef PROBE_DOUBLE
            const int reps = ((PROBE_DOUBLE >> op) & 1) ? 2 : 1;
#else
            const int reps = 1;
#endif
#pragma unroll 1
            for (int rep = 0; rep < reps; ++rep) {
            { GAS unsigned char* w_ = F.ws; GAS float* o_ = F.out; int g_ = F.G, b_ = F.bid, wv_ = F.wave, t_ = F.tid; asm volatile("" : "+s"(w_), "+s"(o_), "+s"(g_), "+s"(b_), "+s"(wv_), "+v"(t_));
              F.ws = w_; F.out = o_;
              F.G = g_; F.bid = b_; F.wave = wv_; F.tid = t_; F.lane = t_ & 63; }
            unsigned char* ws = (unsigned char*)F.ws;
            bf16* Hb = (bf16*)(ws + WS_H); bf16* Ub = (bf16*)(ws + WS_U); bf16* Yb = (bf16*)(ws + WS_Y);
            switch (op) {
            case OP_SWIGLU: if constexpr (PH_ON(OP_SWIGLU)) {
                pg8::Gemm g{Hb, (const bf16*)(ws + (sub ? WS_W13B : WS_W13A)), Mrows, 2 * FF, D}; pg8::StaticOrder S; S.init(Mrows, 2 * FF, F.G, F.bid, D);
                pg8::EpiSwiglu E{Ub};
                pg8::gemm_phase<pg8::EpiSwiglu, pg8::StaticOrder, true, true>(F.lds, g, S, E, F.tid);
            } break;
            case OP_BF16: if constexpr (PH_ON(OP_BF16)) {
                const bf16* A = Hb; const bf16* Bt; int N = D, K = D; bf16 *o0 = Yb, *o1 = Yb, *o2 = Yb, *o3 = Yb, *o4 = Yb; const float* bias = nullptr; int bias_from = 0;
                if (sub == 0) { A = Ub; Bt = (const bf16*)(ws + WS_W2A); K = FF; }
                else if (sub == 1) { A = Ub; Bt = (const bf16*)(ws + WS_W2B); K = FF; }
                else if (sub == 2) { Bt = (const bf16*)(ws + WS_WM) + (size_t)3 * D * D; }
                else if (sub == 3) { Bt = (const bf16*)(ws + WS_WM); N = 5 * D; o0 = Ub; o1 = (bf16*)(ws + WS_U + ACT_BYTES); o2 = (bf16*)(ws + WS_U + 2 * ACT_BYTES);
                                     o3 = (bf16*)(unsigned char*)F.out; o4 = (bf16*)(ws + WS_U + 3 * ACT_BYTES); bias = INP(33); bias_from = 3 * D; }
                else if (sub == 4) { Bt = (const bf16*)(ws + WS_WM) + (size_t)3 * D * D; N = 2 * D; o0 = (bf16*)(unsigned char*)F.out; o1 = (bf16*)(ws + WS_U + 3 * ACT_BYTES); bias = INP(33); }
                else { Bt = (const bf16*)(ws + WS_WM) + (size_t)5 * D * D; }
                const bool split = (Mrows == MALL) && (sub <= 2);
                const pg8::EpiBf16S E{o0, o1, o2, bias, (bf16*)(ws + WS_E), o3, o4, bias_from};
                pg8::Gemm g{A, Bt, Mrows, N, K}; pg8::StaticOrder S;
                if (split) S.init(MLAT, N, F.G, F.bid, K, 2, 32, 128); else S.init(Mrows, N, F.G, F.bid, K);
                pg8::gemm_phase<pg8::EpiBf16S, pg8::StaticOrder, true, true>(F.lds, g, S, E, F.tid);
            } break;
            case OP_GLU: if constexpr (PH_ON(OP_GLU)) {
                pg8::Gemm g{Hb, (const bf16*)(ws + WS_WM), MALL, D, D}; pg8::StaticOrder S; S.init(MALL, D, F.G, F.bid, D);
                pg8::EpiGlu E{Hb, Yb, INP(20)};
                pg8::gemm_phase<pg8::EpiGlu, pg8::StaticOrder, true, true>(F.lds, g, S, E, F.tid);
            } break;
            case OP_QKV_DA: if constexpr (PH_ON(OP_QKV_DA)) {
                pg8::Gemm g{Hb, (const bf16*)(ws + WS_WM), MALL, 3 * D, D}; pg8::StaticOrder S; S.init(MALL, 3 * D, F.G, F.bid, D);
                pg8::EpiQKV<0> E{Ub, (bf16*)(ws + WS_U + ACT_BYTES), (bf16*)(ws + WS_U + 2 * ACT_BYTES), (const float*)(ws + WS_ROPE), (const float*)(ws + WS_ROPE) + 4096 * 32};
                pg8::gemm_phase<pg8::EpiQKV<0>, pg8::StaticOrder, true, true>(F.lds, g, S, E, F.tid);
            } break;
            case OP_QKV_NA: if constexpr (PH_ON(OP_QKV_NA)) {
                pg8::Gemm g{Hb, (const bf16*)(ws + WS_WM), MALL, 3 * D, D}; pg8::StaticOrder S; S.init(MALL, 3 * D, F.G, F.bid, D);
                pg8::EpiQKV<1> E{Ub, (bf16*)(ws + WS_U + ACT_BYTES), (bf16*)(ws + WS_U + 2 * ACT_BYTES), nullptr, nullptr};
                pg8::gemm_phase<pg8::EpiQKV<1>, pg8::StaticOrder, true, true>(F.lds, g, S, E, F.tid);
            } break;
            case OP_NORM: if constexpr (PH_ON(OP_NORM)) {
                const bool last = (li == 3);
                if (sub == 0) norm_phase(F, MALL, false, Yb, INP(7) + (li * 3 + 0) * D, 0.5f, li, 0, INP(6) + (li * 3 + 1) * D, li, 1, false, 2);
                else if (sub == 1) norm_phase(F, last ? MLAT : MALL, false, Yb, INP(7) + (li * 3 + 1) * D, 1.0f, li, 1, INP(6) + (li * 3 + 2) * D, li, 2, false, (li == 1 || li == 2) ? 2 : 0);
                else {
                    if (last) norm_phase(F, MLAT, false, Yb, INP(7) + (li * 3 + 2) * D, 0.5f, li, 2, nullptr, 0, 0, true);
                    else { norm_phase(F, MALL, false, Yb, INP(7) + (li * 3 + 2) * D, 0.5f, li, 2, INP(6) + ((li + 1) * 3 + 0) * D, li + 1, 0, false, 2); __syncthreads(); convert_layer(F, li + 1);
#ifdef PROBE_P0
                        __syncthreads(); convert_layer(F, li + 1);
#endif
                    }
                }
            } break;
            case OP_S5A: if constexpr (PH_ON(OP_S5A)) { s5_pass<false>(F); } break;
            case OP_S5B: if constexpr (PH_ON(OP_S5B)) { s5_pass<true>(F); } break;
            case OP_S5Z: if constexpr (PH_ON(OP_S5Z)) { s5_z_phase(F); } break;
            case OP_ATT_DA: if constexpr (PH_ON(OP_ATT_DA)) { att_da_phase(F); } break;
            case OP_ATT_NA: if constexpr (PH_ON(OP_ATT_NA)) { att_na_phase(F); } break;
            case OP_GLA: if constexpr (PH_ON(OP_GLA)) { gla_phase(F); } break;
            case OP_READOUT: if constexpr (PH_ON(OP_READOUT)) { hg_readout_phase(F); } break;
            default: break;
            }
            if (!(code & NOSYNC)) GSYNC();
            }
#ifdef STOP_AT
            if (li * 12 + st == STOP_AT) {
#ifndef DUMP_KIND
#define DUMP_KIND 0
#define DUMP_OFF WS_X
#define DUMP_N 0
#endif
                if (DUMP_KIND == 0) { const _Float16* X = (const _Float16*)(F.ws + WS_X);
                    for (size_t i = (size_t)F.bid * NTHREADS + F.tid; i < (size_t)MLAT * D; i += (size_t)F.G * NTHREADS) F.out[i] = (float)X[i]; }
                else if (DUMP_KIND == 1) { const bf16* P = (const bf16*)(F.ws + DUMP_OFF);
                    for (size_t i = (size_t)F.bid * NTHREADS + F.tid; i < (size_t)MLAT * D; i += (size_t)F.G * NTHREADS) F.out[i] = bf2f(P[i]); }
                else if (DUMP_KIND == 3) { const bf16* P = (const bf16*)(F.ws + DUMP_OFF); const bf16* P2 = P + (size_t)MALL * D;
                    for (size_t i = (size_t)F.bid * NTHREADS + F.tid; i < (size_t)MLAT * D; i += (size_t)F.G * NTHREADS) F.out[i] = bf2f(P[i]) + bf2f(P2[i]); }
                else { const float* P = (const float*)(F.ws + DUMP_OFF);
                    for (size_t i = (size_t)F.bid * NTHREADS + F.tid; i < (size_t)MLAT * D; i += (size_t)F.G * NTHREADS) F.out[i] = (i < (size_t)DUMP_N) ? P[i] : 0.f; }
                return;
            }
#endif
        }
    }
}

extern "C" void kernel_launch(void* const* d_in, const int* in_sizes, int n_in, void* d_out, int out_size, void* d_ws, size_t ws_size, hipStream_t stream) {
    static int grid = 0;
    if (grid == 0) {
        int dev = 0, cus = 0, per_cu = 0;
        (void)hipGetDevice(&dev);
        (void)hipDeviceGetAttribute(&cus, hipDeviceAttributeMultiprocessorCount, dev);
        if (hipFuncSetAttribute((const void*)mega_fwd, hipFuncAttributeMaxDynamicSharedMemorySize, LDS_BYTES) != hipSuccess) fprintf(stderr, "kernel_launch: hipFuncSetAttribute failed\n");
        if (hipOccupancyMaxActiveBlocksPerMultiprocessor(&per_cu, (const void*)mega_fwd, NTHREADS, LDS_BYTES) != hipSuccess || per_cu < 1) { fprintf(stderr, "kernel_launch: occupancy query gave %d\n", per_cu); per_cu = 1; }
        (void)hipGetLastError();
        if (per_cu > 1) per_cu = 1;
        grid = cus * per_cu;
        if (n_in != 37 || ws_size < WS_NEED) fprintf(stderr, "kernel_launch: n_in %d ws %zu (need %zu)\n", n_in, ws_size, (size_t)WS_NEED);
    }
    (void)hipMemsetAsync((char*)d_ws + WS_BAR, 0, 65536, stream);
    Args a{};
    for (int i = 0; i < 37; ++i) a.in[i] = (const float*)d_in[i];
    a.out = (float*)d_out; a.ws = (unsigned char*)d_ws;
    void* kargs[] = {&a};
    hipError_t e = hipLaunchCooperativeKernel((const void*)mega_fwd, dim3(grid), dim3(NTHREADS), kargs, LDS_BYTES, stream);
    if (e != hipSuccess) fprintf(stderr, "kernel_launch: cooperative launch failed: %s (grid %d)\n", hipGetErrorString(e), grid);
}
```

```cpp
#include <hip/hip_runtime.h>
#include <hip/hip_cooperative_groups.h>
#include <cstdio>
#include <cstdint>
namespace cg = cooperative_groups;
namespace pg8 {
#define PG8_LAS __attribute__((address_space(3)))
typedef unsigned short bf16_t;
typedef short bf16x8 __attribute__((ext_vector_type(8)));
typedef float f32x4 __attribute__((ext_vector_type(4)));
typedef unsigned u32x4 __attribute__((ext_vector_type(4)));
constexpr int BM = 256, BK = 64, HALF = 128, HTB = HALF * BK * 2  , STAGE_BYTES = 8 * HTB, NXCD = 8, WGM = 8;

__host__ __device__ __forceinline__ int lds_byte(int r, int c) { const int st = (r >> 4) * 2 + (c >> 5), rr = r & 15, cc = c & 31, ob = rr * 64 + cc * 2; return st * 1024 + (ob ^ (((ob >> 9) & 1) << 5)); }
__host__ __device__ __forceinline__ void stage_rc(int b, int& R, int& C) { const int st = b / 1024, sb = b % 1024, swz = sb ^ (((sb >> 9) & 1) << 5); R = (st >> 1) * 16 + swz / 64; C = (st & 1) * 32 + (swz % 64) / 2; }
__host__ __device__ __forceinline__ int perm32(int rho) { const int n = rho >> 4, i = rho & 15; return 8 * (i >> 2) + 4 * n + (i & 3); }

struct Unit { int pm, pn, kb, nkt, part; };
struct Gemm { const bf16_t* A; const bf16_t* Bt; int M, N, K; };

struct StaticOrder {
    int nM, nN, nwg, G, c;
    int nktf, P, nsp, pm0;
    __host__ __device__ void init(int M, int N, int G_, int c_, int K_, int P_ = 0, int nsp_ = 0, int pm0_ = 0) { nM = M / BM; nN = N / BM; nwg = nM * nN; G = G_; c = c_; nktf = K_ / BK; P = P_; nsp = nsp_; pm0 = pm0_; }
    __host__ __device__ __forceinline__ bool next(int i, Unit& u) const {
        const long L = (long)i * G + c; if (L >= nwg + nsp * P) return false;
        const bool sp = (L >= nwg);
        const int Pd = P > 0 ? P : 1; const int v = sp ? (int)L - nwg : 0, cu = v / Pd, p = v - cu * Pd;
        int wgid = sp ? 0 : (int)L; { const int q = nwg / NXCD, r = nwg % NXCD, xcd = wgid % NXCD, off = wgid / NXCD; wgid = (xcd < r ? xcd * (q + 1) : r * (q + 1) + (xcd - r) * q) + off; }
        const int nig = WGM * nN, gid = wgid / nig, fm = gid * WGM, gsz = (nM - fm) < WGM ? (nM - fm) : WGM;
        const int pm_n = fm + ((wgid % nig) % gsz), pn_n = (wgid % nig) / gsz;
        const int nk_s = nktf / Pd;
        u.pm = sp ? pm0 + cu / nN : pm_n; u.pn = sp ? cu % nN : pn_n; u.nkt = sp ? nk_s : nktf; u.kb = sp ? p * nk_s : 0; u.part = sp ? p : -1;
        return true;
    }
    __device__ __forceinline__ void a_ready(const Unit&) const {}
    __device__ __forceinline__ void done(const Unit&) const {}
};
typedef float f32x2_cv __attribute__((ext_vector_type(2))); typedef __bf16 bf16x2_cv __attribute__((ext_vector_type(2)));
__device__ __forceinline__ unsigned cvt_pk_bf16(float lo, float hi) { f32x2_cv v = {lo, hi}; bf16x2_cv b = __builtin_convertvector(v, bf16x2_cv); return __builtin_bit_cast(unsigned, b); }
typedef unsigned u32x2 __attribute__((ext_vector_type(2)));
#define PG8_GAS __attribute__((address_space(1)))
__device__ __forceinline__ float fast_sigmoid(float x) { return __builtin_amdgcn_rcpf(1.0f + __builtin_amdgcn_exp2f(-1.4426950408889634f * x)); }
__device__ __forceinline__ float bf2f(unsigned short b) { return __uint_as_float(((unsigned)b) << 16); }
constexpr int E_FF = 2816, E_D = 1024, E_TALL = 4352, E_MLAT = 32768;

struct EpiSwiglu {
    static constexpr bool PERM = true, AFTER_DRAIN = false;
    bf16_t* U;
    __device__ __forceinline__ void operator()(const f32x4 (&acc)[2][2][4][2], const Unit& u, int wr, int wc, int fr, int fq) const {
        const int row0 = u.pm * BM + wr * 64 + fr, col0 = u.pn * 128 + wc * 32 + 8 * fq;
#pragma unroll
        for (int ai = 0; ai < 2; ++ai)
#pragma unroll
            for (int m = 0; m < 4; ++m) {
                bf16_t* rowp = U + (size_t)(row0 + ai * HALF + m * 16) * E_FF + col0;
                float r[8];
#pragma unroll
                for (int n = 0; n < 2; ++n)
#pragma unroll
                    for (int j = 0; j < 4; ++j) { const float a = acc[ai][0][m][n][j], g = acc[ai][1][m][n][j]; r[4 * n + j] = a * fast_sigmoid(a) * g; }
                u32x4 w; w.x = cvt_pk_bf16(r[0], r[1]); w.y = cvt_pk_bf16(r[2], r[3]); w.z = cvt_pk_bf16(r[4], r[5]); w.w = cvt_pk_bf16(r[6], r[7]);
                *(u32x4*)rowp = w;
            }
    }
};
struct EpiBf16S {
    static constexpr bool PERM = true, AFTER_DRAIN = false;
    bf16_t *O0, *O1, *O2; const float* bias; bf16_t* OP; bf16_t *O3, *O4; int bias_from;
    __device__ __forceinline__ void operator()(const f32x4 (&acc)[2][2][4][2], const Unit& u, int wr, int wc, int fr, int fq) const {
        const int row0 = u.pm * BM + wr * 64 + fr; const int colt = u.pn * BM; const int t = colt >> 10;
        PG8_GAS bf16_t* base = (PG8_GAS bf16_t*)((unsigned long long)O0 + (unsigned long long)(t == 1) * ((unsigned long long)O1 - (unsigned long long)O0) + (unsigned long long)(t == 2) * ((unsigned long long)O2 - (unsigned long long)O0)
            + (unsigned long long)(t == 3) * ((unsigned long long)O3 - (unsigned long long)O0) + (unsigned long long)(t == 4) * ((unsigned long long)O4 - (unsigned long long)O0));
        if (u.part >= 0) base = (PG8_GAS bf16_t*)OP + ((long)u.part * 2048 - (long)E_MLAT) * E_D;
        const int col0 = (colt & 1023) + wc * 32 + 8 * fq, bcol0 = colt - bias_from + wc * 32 + 8 * fq;
        const bool hasb = (bias != nullptr) && (colt >= bias_from);
        f32x4 bv[2][2];
#pragma unroll
        for (int bj = 0; bj < 2; ++bj)
#pragma unroll
            for (int n = 0; n < 2; ++n) bv[bj][n] = hasb ? *(const f32x4*)(bias + bcol0 + bj * HALF + 4 * n) : (f32x4){0.f, 0.f, 0.f, 0.f};
#pragma unroll
        for (int ai = 0; ai < 2; ++ai)
#pragma unroll
            for (int m = 0; m < 4; ++m) { PG8_GAS bf16_t* rowp = base + (size_t)(row0 + ai * HALF + m * 16) * E_D + col0;
#pragma unroll
                for (int bj = 0; bj < 2; ++bj) { const f32x4 v0 = acc[ai][bj][m][0] + bv[bj][0], v1 = acc[ai][bj][m][1] + bv[bj][1];
                    u32x4 w; w.x = cvt_pk_bf16(v0[0], v0[1]); w.y = cvt_pk_bf16(v0[2], v0[3]); w.z = cvt_pk_bf16(v1[0], v1[1]); w.w = cvt_pk_bf16(v1[2], v1[3]);
                    *(PG8_GAS u32x4*)(rowp + bj * HALF) = w; } }
    }
};
struct EpiGlu {
    static constexpr bool PERM = true, AFTER_DRAIN = false;
    const bf16_t* Z; bf16_t* O; const float* bias;
    __device__ __forceinline__ void operator()(const f32x4 (&acc)[2][2][4][2], const Unit& u, int wr, int wc, int fr, int fq) const {
        const int row0 = u.pm * BM + wr * 64 + fr; const int col0 = u.pn * BM + wc * 32 + 8 * fq;
#pragma unroll
        for (int ai = 0; ai < 2; ++ai)
#pragma unroll
            for (int m = 0; m < 4; ++m) { const size_t ro = (size_t)(row0 + ai * HALF + m * 16) * E_D + col0;
#pragma unroll
                for (int bj = 0; bj < 2; ++bj) {
                    const u32x4 z = *(const u32x4*)(Z + ro + bj * HALF);
                    const f32x4 b0 = *(const f32x4*)(bias + col0 + bj * HALF), b1 = *(const f32x4*)(bias + col0 + bj * HALF + 4);
                    const f32x4 v0 = acc[ai][bj][m][0] + b0, v1 = acc[ai][bj][m][1] + b1;
                    float r[8];
                    const unsigned zz[4] = {z.x, z.y, z.z, z.w};
#pragma unroll
                    for (int j = 0; j < 4; ++j) {
                        const float zl = __uint_as_float(zz[j] << 16), zh = __uint_as_float(zz[j] & 0xffff0000u);
                        const float s0 = fast_sigmoid(j < 2 ? v0[2 * j] : v1[2 * j - 4]), s1 = fast_sigmoid(j < 2 ? v0[2 * j + 1] : v1[2 * j - 3]);
                        r[2 * j] = zl * s0; r[2 * j + 1] = zh * s1; }
                    u32x4 w; w.x = cvt_pk_bf16(r[0], r[1]); w.y = cvt_pk_bf16(r[2], r[3]); w.z = cvt_pk_bf16(r[4], r[5]); w.w = cvt_pk_bf16(r[6], r[7]);
                    *(u32x4*)(O + ro + bj * HALF) = w; } }
    }
};
template <int MODE> struct EpiQKV {
    static constexpr bool PERM = true, AFTER_DRAIN = false;
    bf16_t *Q, *K, *Vt; const float* rcos; const float* rsin;
    __device__ __forceinline__ void operator()(const f32x4 (&acc)[2][2][4][2], const Unit& u, int wr, int wc, int fr, int fq) const {
        const int colt = u.pn * BM; const int sec = colt >> 10;
        const bool lat = (u.pm * BM) < E_MLAT;
#pragma unroll
        for (int ai = 0; ai < 2; ++ai)
#pragma unroll
            for (int m = 0; m < 4; ++m) {
                const int r = u.pm * BM + ai * HALF + wr * 64 + m * 16 + fr;
                int b, t, s;
                if (lat) { b = r >> 12; t = r & 4095; s = 256 + t; } else { const int rr = r - E_MLAT; b = rr >> 8; t = rr & 255; s = t; }
#pragma unroll
                for (int bj = 0; bj < 2; ++bj) {
                    const int cb = (colt & 1023) + bj * HALF + wc * 32 + 8 * fq;
                    float e[8];
#pragma unroll
                    for (int j = 0; j < 4; ++j) { e[j] = acc[ai][bj][m][0][j]; e[4 + j] = acc[ai][bj][m][1][j]; }
                    if (sec < 2) {
                        const int hd = cb >> 6, dd = cb & 63;
                        if (MODE == 0 && lat) {
                            const f32x4 cs = *(const f32x4*)(rcos + t * 32 + (dd >> 1)), sn = *(const f32x4*)(rsin + t * 32 + (dd >> 1));
#pragma unroll
                            for (int j = 0; j < 4; ++j) { const float x1 = e[2 * j], x2 = e[2 * j + 1]; e[2 * j] = x1 * cs[j] - x2 * sn[j]; e[2 * j + 1] = x1 * sn[j] + x2 * cs[j]; }
                        }
                        if (sec == 0) {
#pragma unroll
                            for (int j = 0; j < 8; ++j) e[j] *= 0.125f * 1.4426950408889634f;
                        }
                        bf16_t* dst = (sec ? K : Q) + ((size_t)(b * 16 + hd) * E_TALL + s) * 64 + dd;
                        u32x4 w; w.x = cvt_pk_bf16(e[0], e[1]); w.y = cvt_pk_bf16(e[2], e[3]); w.z = cvt_pk_bf16(e[4], e[5]); w.w = cvt_pk_bf16(e[6], e[7]);
                        *(u32x4*)dst = w;
                    } else {
                        const int vh = (MODE == 0) ? (cb >> 7) : (cb >> 6), dv = (MODE == 0) ? (cb & 127) : (cb & 63);
                        constexpr int NVH = (MODE == 0) ? 8 : 16, DVV = (MODE == 0) ? 128 : 64;
                        bf16_t* dst = Vt + ((size_t)(b * NVH + vh) * DVV + dv) * E_TALL + s;
#pragma unroll
                        for (int j = 0; j < 4; ++j) { const unsigned pk = cvt_pk_bf16(e[2 * j], e[2 * j + 1]); dst[(size_t)(2 * j) * E_TALL] = (bf16_t)(pk & 0xffffu); dst[(size_t)(2 * j + 1) * E_TALL] = (bf16_t)(pk >> 16); }
                    }
                    asm volatile("" ::: "memory");
                }
            }
    }
};
template <class Epi, class Sched, bool ALIGN_EPI = false, bool SP2 = false>
__device__ __forceinline__ void gemm_phase(PG8_LAS unsigned char* lds, const Gemm g, const Sched& S, const Epi& E, const int tid) {
    const int wid = __builtin_amdgcn_readfirstlane(tid >> 6), lane = tid & 63, wr = wid >> 2, wc = wid & 3, fr = lane & 15, fq = lane >> 4;
    const int K = g.K;
    unsigned voffA[2], voffB[2];
#pragma unroll
    for (int i = 0; i < 2; ++i) { int R, C; stage_rc(tid * 16 + i * 8192, R, C); const int Rb = Epi::PERM ? ((R & ~31) + perm32(R & 31)) : R;
        voffA[i] = (unsigned)(R * K + C) * 2u; voffB[i] = (unsigned)(Rb * K + C) * 2u; }
    const size_t kstep = (size_t)(BK * 2);
    const size_t hstep = (size_t)HALF * K * 2;
    const size_t tstep = 2 * hstep;
    const unsigned ldsw = (unsigned)wid * 1024u;
    const int aoff = lds_byte(wr * 64 + fr, fq * 8), boff = lds_byte(wc * 32 + fr, fq * 8);
#define PG8_SA(b, h) (((b) * 2 + (h)) * HTB)
#define PG8_SB(b, h) ((4 + (b) * 2 + (h)) * HTB)
#define PG8_STAGE(bufoff, gbase, voff) do { _Pragma("unroll") for (int _i = 0; _i < 2; ++_i) \
        __builtin_amdgcn_global_load_lds((const unsigned*)((const char*)(gbase) + (voff)[_i]), (PG8_LAS unsigned*)(lds + (bufoff) + ldsw + _i * 8192), 16, 0, 0); } while (0)
#define PG8_LDA(dst, b, h) do { _Pragma("unroll") for (int m = 0; m < 4; ++m) _Pragma("unroll") for (int k = 0; k < 2; ++k) dst[m][k] = *(const PG8_LAS bf16x8*)(lds + PG8_SA(b, h) + aoff + m * 2048 + k * 1024); } while (0)
#define PG8_LDB(dst, b, h) do { _Pragma("unroll") for (int n = 0; n < 2; ++n) _Pragma("unroll") for (int k = 0; k < 2; ++k) dst[n][k] = *(const PG8_LAS bf16x8*)(lds + PG8_SB(b, h) + boff + n * 2048 + k * 1024); } while (0)
#define PG8_MMA(ai, bj, At, Bt) do { __builtin_amdgcn_s_setprio(1); _Pragma("unroll") for (int m = 0; m < 4; ++m) _Pragma("unroll") for (int n = 0; n < 2; ++n) _Pragma("unroll") for (int k = 0; k < 2; ++k) \
        acc[ai][bj][m][n] = __builtin_amdgcn_mfma_f32_16x16x32_bf16(Bt[n][k], At[m][k], acc[ai][bj][m][n], 0, 0, 0); __builtin_amdgcn_s_setprio(0); } while (0)
#define PG8_WAIT_V(n) asm volatile("s_waitcnt vmcnt(" #n ")" ::: "memory")
#define PG8_WAIT_L(n) asm volatile("s_waitcnt lgkmcnt(" #n ")" ::: "memory")
#define PG8_BAR __builtin_amdgcn_s_barrier()
#define PG8_SCHED __builtin_amdgcn_sched_barrier(0)
    Unit cur, nxt; int ui = 0;
    if (!S.next(0, cur)) return;
    f32x4 acc[2][2][4][2];
#pragma unroll
    for (int a = 0; a < 2; ++a)
#pragma unroll
        for (int b = 0; b < 2; ++b)
#pragma unroll
            for (int m = 0; m < 4; ++m)
#pragma unroll
                for (int n = 0; n < 2; ++n) acc[a][b][m][n] = (f32x4){0.f, 0.f, 0.f, 0.f};
    bf16x8 At[4][2], B0[2][2], B1[2][2];
    const char* cA = (const char*)g.A + (size_t)cur.pm * tstep + (size_t)cur.kb * kstep; const char* cB = (const char*)g.Bt + (size_t)cur.pn * tstep + (size_t)cur.kb * kstep;
    S.a_ready(cur);
    if constexpr (SP2) {
        PG8_STAGE(PG8_SB(0, 0), cB, voffB); PG8_STAGE(PG8_SB(0, 1), cB + hstep, voffB); PG8_STAGE(PG8_SA(0, 0), cA, voffA); PG8_STAGE(PG8_SA(0, 1), cA + hstep, voffA);
        if (wr == 1) PG8_BAR;
        PG8_WAIT_V(2); PG8_BAR;
        PG8_STAGE(PG8_SB(1, 0), cB + kstep, voffB); PG8_STAGE(PG8_SA(1, 0), cA + kstep, voffA); PG8_STAGE(PG8_SB(1, 1), cB + hstep + kstep, voffB);
        PG8_WAIT_V(6); PG8_BAR;
    } else {
        PG8_STAGE(PG8_SB(0, 0), cB, voffB); PG8_STAGE(PG8_SA(0, 0), cA, voffA); PG8_STAGE(PG8_SB(0, 1), cB + hstep, voffB); PG8_STAGE(PG8_SA(0, 1), cA + hstep, voffA);
        if (wr == 1) PG8_BAR;
        PG8_WAIT_V(4); PG8_BAR;
        PG8_STAGE(PG8_SB(1, 0), cB + kstep, voffB); PG8_STAGE(PG8_SA(1, 0), cA + kstep, voffA); PG8_STAGE(PG8_SB(1, 1), cB + hstep + kstep, voffB);
        PG8_WAIT_V(6); PG8_BAR;
    }
    for (;;) {
        const bool has_next = S.next(ui + 1, nxt);
        const char* nA = has_next ? (const char*)g.A + (size_t)nxt.pm * tstep + (size_t)nxt.kb * kstep : cA; const char* nB = has_next ? (const char*)g.Bt + (size_t)nxt.pn * tstep + (size_t)nxt.kb * kstep : cB;
        const int nt = cur.nkt;
        for (int t = 0; t < nt; t += 2) {
            const bool last = (t == nt - 2);
            const char* a1 = cA + (size_t)(t + 1) * kstep;
            const char* a2 = last ? nA : cA + (size_t)(t + 2) * kstep; const char* b2 = last ? nB : cB + (size_t)(t + 2) * kstep;
            const char* a3 = a2 + kstep; const char* b3 = b2 + kstep;
            if (last && has_next) S.a_ready(nxt);
            if constexpr (SP2) {
            PG8_LDB(B0, 0, 0); PG8_LDB(B1, 0, 1); PG8_SCHED; PG8_LDA(At, 0, 0); PG8_STAGE(PG8_SA(1, 1), a1 + hstep, voffA);
            PG8_WAIT_V(8); PG8_WAIT_L(0); PG8_BAR; PG8_MMA(0, 0, At, B0); PG8_MMA(0, 1, At, B1); PG8_BAR; PG8_SCHED;
            PG8_LDA(At, 0, 1); PG8_STAGE(PG8_SB(0, 0), b2, voffB); PG8_STAGE(PG8_SB(0, 1), b2 + hstep, voffB); PG8_STAGE(PG8_SA(0, 0), a2, voffA);
            PG8_WAIT_V(8); PG8_WAIT_L(0); PG8_BAR; PG8_MMA(1, 0, At, B0); PG8_MMA(1, 1, At, B1); PG8_BAR; PG8_SCHED;
            PG8_LDB(B0, 1, 0); PG8_LDB(B1, 1, 1); PG8_SCHED; PG8_LDA(At, 1, 0); PG8_STAGE(PG8_SA(0, 1), a2 + hstep, voffA);
            PG8_WAIT_V(8); PG8_WAIT_L(0); PG8_BAR; PG8_MMA(0, 0, At, B0); PG8_MMA(0, 1, At, B1); PG8_BAR; PG8_SCHED;
            PG8_LDA(At, 1, 1); PG8_STAGE(PG8_SB(1, 0), b3, voffB); PG8_STAGE(PG8_SB(1, 1), b3 + hstep, voffB); PG8_STAGE(PG8_SA(1, 0), a3, voffA);
            PG8_WAIT_V(8); PG8_WAIT_L(0); PG8_BAR; PG8_MMA(1, 0, At, B0); PG8_MMA(1, 1, At, B1); PG8_BAR; PG8_SCHED;
            } else {
            PG8_LDB(B0, 0, 0); PG8_SCHED; PG8_LDA(At, 0, 0); PG8_STAGE(PG8_SA(1, 1), a1 + hstep, voffA);
            PG8_WAIT_L(8); PG8_BAR; PG8_WAIT_L(0); PG8_MMA(0, 0, At, B0); PG8_BAR; PG8_SCHED;
            PG8_LDB(B1, 0, 1); PG8_STAGE(PG8_SB(0, 0), b2, voffB);
            PG8_BAR; PG8_WAIT_L(0); PG8_MMA(0, 1, At, B1); PG8_BAR;
            PG8_LDA(At, 0, 1); PG8_STAGE(PG8_SA(0, 0), a2, voffA);
            PG8_BAR; PG8_WAIT_L(0); PG8_MMA(1, 0, At, B0); PG8_BAR; PG8_SCHED;
            PG8_STAGE(PG8_SB(0, 1), b2 + hstep, voffB);
            PG8_WAIT_V(6); PG8_BAR; PG8_MMA(1, 1, At, B1); PG8_BAR;
            PG8_LDB(B0, 1, 0); PG8_SCHED; PG8_LDA(At, 1, 0); PG8_STAGE(PG8_SA(0, 1), a2 + hstep, voffA);
            PG8_WAIT_L(8); PG8_BAR; PG8_WAIT_L(0); PG8_MMA(0, 0, At, B0); PG8_BAR; PG8_SCHED;
            PG8_LDB(B1, 1, 1); PG8_STAGE(PG8_SB(1, 0), b3, voffB);
            PG8_BAR; PG8_WAIT_L(0); PG8_MMA(0, 1, At, B1); PG8_BAR;
            PG8_LDA(At, 1, 1); PG8_STAGE(PG8_SA(1, 0), a3, voffA);
            PG8_BAR; PG8_WAIT_L(0); PG8_MMA(1, 0, At, B0); PG8_BAR; PG8_SCHED;
            PG8_STAGE(PG8_SB(1, 1), b3 + hstep, voffB);
            PG8_WAIT_V(6); PG8_BAR; PG8_MMA(1, 1, At, B1); PG8_BAR;
            }
        }
        if constexpr (ALIGN_EPI) { if (wr == 0) PG8_BAR; }
        if constexpr (!Epi::AFTER_DRAIN) { E(acc, cur, wr, wc, fr, fq); S.done(cur); }
        if (!has_next) break;
#pragma unroll
        for (int a = 0; a < 2; ++a)
#pragma unroll
            for (int b = 0; b < 2; ++b)
#pragma unroll
                for (int m = 0; m < 4; ++m)
#pragma unroll
                    for (int n = 0; n < 2; ++n) acc[a][b][m][n] = (f32x4){0.f, 0.f, 0.f, 0.f};
        cur = nxt; cA = nA; cB = nB; ++ui;
        if constexpr (ALIGN_EPI) { if (wr == 1) PG8_BAR; }
    }
    PG8_WAIT_V(0);
    if constexpr (!ALIGN_EPI) { if (wr == 0) PG8_BAR; }
    PG8_BAR;
    if constexpr (Epi::AFTER_DRAIN) { E.fused(acc, cur, wr, wc, fr, fq, lds, wid, lane); S.done(cur); }
#undef PG8_SA
#undef PG8_SB
#undef PG8_STAGE
#undef PG8_LDA
#undef PG8_LDB
#undef PG8_MMA
#undef PG8_WAIT_V
#undef PG8_WAIT_L
#undef PG8_BAR
#undef PG8_SCHED
}
}
#define LAS __attribute__((address_space(3)))
#define GAS __attribute__((address_space(1)))
typedef unsigned short bf16;
typedef float f32x4 __attribute__((ext_vector_type(4)));
typedef float f32x16 __attribute__((ext_vector_type(16)));
typedef short bf16x8 __attribute__((ext_vector_type(8)));
typedef short s16x4 __attribute__((ext_vector_type(4)));
typedef unsigned u32x4 __attribute__((ext_vector_type(4)));
typedef unsigned u32x2 __attribute__((ext_vector_type(2)));
typedef _Float16 h16x4 __attribute__((ext_vector_type(4)));

constexpr int D = 1024, NB = 8, SEQ = 4096, CTX = 256, TALL = 4352, MLAT = NB * SEQ, MCTX = NB * CTX, MALL = MLAT + MCTX, FF = 2816;
constexpr float RMS_EPS = 1e-6f, LOG2E = 1.4426950408889634f;
constexpr int NTHREADS = 512, NWAVES = 8;
constexpr int LDS_BYTES = 147456;

constexpr size_t MiB = 1u << 20;
constexpr size_t WS_BAR = 0;
constexpr size_t WS_MOD = 1 * MiB;
constexpr size_t WS_ROPE = 3 * MiB;
constexpr size_t WS_S5LAM = 4 * MiB;
constexpr size_t WS_S5B = 4 * MiB + 256 * 1024;
constexpr size_t WS_S5C = 5 * MiB;
constexpr size_t WS_W13A = 8 * MiB, WS_W2A = 19 * MiB, WS_W13B = 25 * MiB, WS_W2B = 36 * MiB, WS_WM = 42 * MiB;
constexpr size_t WS_X = 56 * MiB;
constexpr size_t WS_H = 192 * MiB;
constexpr size_t WS_U = 260 * MiB;
constexpr size_t WS_Y = 447 * MiB;
constexpr size_t WS_E = 515 * MiB;
constexpr size_t ACT_BYTES = (size_t)MALL * D * 2;
constexpr size_t WS_NEED = 600 * MiB;

struct Args { const float* in[37]; float* out; unsigned char* ws; };

struct Frame {
    LAS unsigned char* lds;
    int tid, lane, wave, G, bid;
    LAS unsigned long long* ptab; GAS float* out; GAS unsigned char* ws;
};
__device__ __forceinline__ const float* inp_(const Frame& F, int i) { const unsigned long long v = F.ptab[i]; const unsigned lo = __builtin_amdgcn_readfirstlane((unsigned)v), hi = __builtin_amdgcn_readfirstlane((unsigned)(v >> 32)); return (const float*)(GAS const float*)(((unsigned long long)hi << 32) | lo); }
#define INP(i) inp_(F, (i))

__device__ __forceinline__ unsigned f2bf(float f) { unsigned u = __builtin_bit_cast(unsigned, f); return (u + 0x7fffu + ((u >> 16) & 1u)) >> 16; }
__device__ __forceinline__ unsigned pk2(float lo, float hi) { return pg8::cvt_pk_bf16(lo, hi); }
__device__ __forceinline__ float bf2f(unsigned short b) { return __uint_as_float(((unsigned)b) << 16); }
__device__ __forceinline__ float bflo(unsigned w) { return __uint_as_float(w << 16); }
__device__ __forceinline__ float bfhi(unsigned w) { return __uint_as_float(w & 0xffff0000u); }
__device__ __forceinline__ float wave_sum(float v) {
#pragma unroll
    for (int o = 1; o < 64; o <<= 1) v += __shfl_xor(v, o);
    return v;
}
__device__ __forceinline__ float fexp(float x) { return __builtin_amdgcn_exp2f(x * LOG2E); }
__device__ __forceinline__ float fsigmoid(float x) { return __builtin_amdgcn_rcpf(1.0f + __builtin_amdgcn_exp2f(-LOG2E * x)); }
__device__ __forceinline__ int crow(int r, int hi) { return (r & 3) + 8 * (r >> 2) + 4 * hi; }
#define LBAR() asm volatile("s_waitcnt lgkmcnt(0)\n\ts_barrier" ::: "memory")
#define MFMA32(a, b, c) __builtin_amdgcn_mfma_f32_32x32x16_bf16((a), (b), (c), 0, 0, 0)
#define MFMA16(a, b, c) __builtin_amdgcn_mfma_f32_16x16x32_bf16((a), (b), (c), 0, 0, 0)

__device__ __forceinline__ void cvt_item(const float* W, int K, int N, bf16* WT, int mode, int row_off, LAS float* scr, int item, int lane) {
    const int nblk = N / 32, kb = item / nblk, nb = item % nblk, k0 = 64 * kb, n0 = 32 * nb;
#pragma unroll
    for (int i = 0; i < 8; ++i) { const int kk = 8 * i + (lane >> 3), c4 = 4 * (lane & 7);
        const f32x4 v = *(const f32x4*)(W + (size_t)(k0 + kk) * N + n0 + c4);
        scr[kk * 33 + c4] = v[0]; scr[kk * 33 + c4 + 1] = v[1]; scr[kk * 33 + c4 + 2] = v[2]; scr[kk * 33 + c4 + 3] = v[3]; }
    asm volatile("s_waitcnt lgkmcnt(0)" ::: "memory");
    const int c = lane & 7;
    const int drow0 = (mode == 0) ? (row_off + n0) : ((n0 >> 7) * 256 + (mode - 1) * 128 + (n0 & 127));
#pragma unroll
    for (int j = 0; j < 4; ++j) { const int n = (lane >> 3) + 8 * j; const LAS float* s = scr + (8 * c) * 33 + n;
        u32x4 o; o.x = pk2(s[0 * 33], s[1 * 33]); o.y = pk2(s[2 * 33], s[3 * 33]); o.z = pk2(s[4 * 33], s[5 * 33]); o.w = pk2(s[6 * 33], s[7 * 33]);
        *(u32x4*)(WT + (size_t)(drow0 + n) * K + k0 + 8 * c) = o; }
    asm volatile("s_waitcnt lgkmcnt(0)" ::: "memory");
}
__device__ __forceinline__ void convert_layer(Frame& F, int li) {
    LAS float* scr = (LAS float*)(F.lds + F.wave * 16384);
    const int gw = F.bid * NWAVES + F.wave, NGW = F.G * NWAVES;
    constexpr int I_UP = (D / 64) * (FF / 32), I_DN = (FF / 64) * (D / 32), I_SQ = (D / 64) * (D / 32);
    const int n_mix = (li == 0) ? I_SQ : (li == 3 ? 6 * I_SQ : 4 * I_SQ);
    const int NITEMS = 4 * I_UP + 2 * I_DN + n_mix;
    bf16* w13a = (bf16*)(F.ws + WS_W13A); bf16* w2a = (bf16*)(F.ws + WS_W2A); bf16* w13b = (bf16*)(F.ws + WS_W13B); bf16* w2b = (bf16*)(F.ws + WS_W2B); bf16* wm = (bf16*)(F.ws + WS_WM);
    const size_t offA = (size_t)(li * 2 + 0) * D * FF, offB = (size_t)(li * 2 + 1) * D * FF;
    for (int it = gw; it < NITEMS; it += NGW) {
        int r = it;
        if (r < I_UP) { cvt_item(INP(8) + offA, D, FF, w13a, 1, 0, scr, r, F.lane); continue; } r -= I_UP;
        if (r < I_UP) { cvt_item(INP(9) + offA, D, FF, w13a, 2, 0, scr, r, F.lane); continue; } r -= I_UP;
        if (r < I_DN) { cvt_item(INP(10) + offA, FF, D, w2a, 0, 0, scr, r, F.lane); continue; } r -= I_DN;
        if (r < I_UP) { cvt_item(INP(8) + offB, D, FF, w13b, 1, 0, scr, r, F.lane); continue; } r -= I_UP;
        if (r < I_UP) { cvt_item(INP(9) + offB, D, FF, w13b, 2, 0, scr, r, F.lane); continue; } r -= I_UP;
        if (r < I_DN) { cvt_item(INP(10) + offB, FF, D, w2b, 0, 0, scr, r, F.lane); continue; } r -= I_DN;
        if (li == 0) { cvt_item(INP(19), D, D, wm, 0, 0, scr, r, F.lane); continue; }
        if (li == 1 || li == 2) {
            const float* wqkv = INP(li == 1 ? 21 : 28); const float* wo = INP(li == 1 ? 22 : 29);
            if (r < 3 * I_SQ) { cvt_item(wqkv, D, 3 * D, wm, 0, 0, scr, r, F.lane); continue; } r -= 3 * I_SQ;
            cvt_item(wo, D, D, wm + (size_t)3 * D * D, 0, 0, scr, r, F.lane); continue;
        }
        if (r < 3 * I_SQ) { cvt_item(INP(31), D, 3 * D, wm, 0, 0, scr, r, F.lane); continue; } r -= 3 * I_SQ;
        if (r < I_SQ) { cvt_item(INP(32), D, D, wm + (size_t)3 * D * D, 0, 0, scr, r, F.lane); continue; } r -= I_SQ;
        if (r < I_SQ) { cvt_item(INP(32) + (size_t)D * D, D, D, wm + (size_t)4 * D * D, 0, 0, scr, r, F.lane); continue; } r -= I_SQ;
        cvt_item(INP(36), D, D, wm + (size_t)5 * D * D, 0, 0, scr, r, F.lane);
    }
}

__device__ __forceinline__ void phase_p0(Frame& F) {
    {
        LAS float* sc = (LAS float*)F.lds;
        LAS float* red = (LAS float*)(F.lds + 40960);
        for (int i = F.tid; i < 9 * 1024; i += NTHREADS) { const int bi = i >> 10, k = i & 1023; const float v = (bi < 8) ? INP(1)[bi * 1024 + k] : INP(3)[k]; sc[i] = v * fsigmoid(v); }
        __syncthreads();
        float* MOD = (float*)(F.ws + WS_MOD);
        const int col = F.tid & 31, ks = F.tid >> 5;
        for (int u = F.bid; u < 4 * 288; u += F.G) {
            const int li = u / 288, c0 = (u % 288) * 32;
            const float* W = INP(4) + (size_t)li * D * 9216 + c0 + col;
            float acc[9];
#pragma unroll
            for (int b = 0; b < 9; ++b) acc[b] = 0.f;
#pragma unroll 2
            for (int k4 = 0; k4 < 16; ++k4) {
                const int k = ks * 64 + k4 * 4;
                const float w0 = W[(size_t)(k + 0) * 9216], w1 = W[(size_t)(k + 1) * 9216], w2 = W[(size_t)(k + 2) * 9216], w3 = W[(size_t)(k + 3) * 9216];
#pragma unroll
                for (int b = 0; b < 9; ++b) { const f32x4 s = *(const LAS f32x4*)(sc + b * 1024 + k); acc[b] += s[0] * w0 + s[1] * w1 + s[2] * w2 + s[3] * w3; }
            }
#pragma unroll
            for (int b = 0; b < 9; ++b) red[(ks * 9 + b) * 32 + col] = acc[b];
            __syncthreads();
            if (F.tid < 288) { const int b = F.tid >> 5, cc = F.tid & 31; float s = 0.f;
#pragma unroll
                for (int q = 0; q < 16; ++q) s += red[(q * 9 + b) * 32 + cc];
                MOD[(size_t)(li * 9 + b) * 9216 + c0 + cc] = s + INP(5)[li * 9216 + c0 + cc]; }
            __syncthreads();
        }
    }
    const int gt = F.bid * NTHREADS + F.tid, NGT = F.G * NTHREADS;
    {
        float* rc = (float*)(F.ws + WS_ROPE); float* rs = rc + 4096 * 32;
        for (int i = gt; i < 4096 * 32; i += NGT) { const int t = i >> 5, p = i & 31;
            const float inv = exp2f(-(float)(p & 15) * (13.287712379549449f / 16.0f));
            const float pos = (p < 16) ? (float)(t >> 6) : (float)(t & 63);
            float s, c; sincosf(pos * inv, &s, &c); rc[i] = c; rs[i] = s; }
    }
    {
        float* LAM = (float*)(F.ws + WS_S5LAM); bf16* BM_ = (bf16*)(F.ws + WS_S5B); bf16* CM_ = (bf16*)(F.ws + WS_S5C);
        const float *a_re = INP(11), *a_im = INP(12), *ldt = INP(13), *b_re = INP(14), *b_im = INP(15), *c_re = INP(16), *c_im = INP(17);
        for (int i = gt; i < 2 * 64 * 64; i += NGT) { const int dg = i >> 6;
            const float dt = expf(ldt[dg]); const float ar = a_re[i], ai = a_im[i];
            const float mag = expf(ar * dt); float s, c; sincosf(ai * dt, &s, &c);
            LAM[2 * i] = mag * c; LAM[2 * i + 1] = mag * s; }
        for (int i = gt; i < 2 * 64 * 4 * 64 * 8; i += NGT) {
            const int j = i & 7, ln = (i >> 3) & 63, cb = (i >> 9) & 3, dg = i >> 11;
            const int p = (ln & 31) + 32 * (cb >> 1), n = 8 * (ln >> 5) + j;
            const int ip = dg * 64 + p;
            const float dt = expf(ldt[dg]); const float ar = a_re[ip], ai = a_im[ip];
            const float mag = expf(ar * dt); float s, c; sincosf(ai * dt, &s, &c);
            const float nr = mag * c - 1.0f, ni = mag * s;
            const float den = 1.0f / (ar * ar + ai * ai);
            const float qr = (nr * ar + ni * ai) * den, qi = (ni * ar - nr * ai) * den;
            const float br = b_re[(size_t)ip * 16 + n], bi = b_im[(size_t)ip * 16 + n];
            const float vr = qr * br - qi * bi, vi = qr * bi + qi * br;
            BM_[i] = (bf16)f2bf((cb & 1) ? vi : vr);
        }
        for (int i = gt; i < 2 * 64 * 4 * 64 * 8; i += NGT) {
            const int j = i & 7, ln = (i >> 3) & 63, kc = (i >> 9) & 3, dg = i >> 11;
            const int n = ln & 15, p = 16 * kc + 4 * (ln >> 4) + (j >> 1);
            const size_t ic = ((size_t)dg * 16 + n) * 64 + p;
            CM_[i] = (bf16)f2bf((j & 1) ? -c_im[ic] : c_re[ic]);
        }
    }
    __syncthreads();
    convert_layer(F, 0);
}

__device__ __forceinline__ void norm_phase(Frame& F, int nrows, bool init, const bf16* Y, const float* gpost, float wgt, int mli, int mj, const float* gpre, int nli, int nj, bool fin, int ysplit = 0) {
    const int gw = F.bid * NWAVES + F.wave, NGW = F.G * NWAVES;
    _Float16* X = (_Float16*)(F.ws + WS_X); bf16* H = (bf16*)(F.ws + WS_H); const float* MOD = (const float*)(F.ws + WS_MOD);
    const int lo = 4 * F.lane;
    const int nlat = nrows < MLAT ? nrows : MLAT;
    const int chunk = (nlat + NGW - 1) / NGW;
    const int rbeg = gw * chunk, rend = (rbeg + chunk < nlat) ? rbeg + chunk : nlat;
    int crow = MLAT + gw; bool ctxmode = false;
    f32x4 pg[4], ps1[4], ps0[4], cgp[4], cgr[4];
    int cur_bi = -1;
    u32x2 pxr[2][4], pyr[2][4]; int pf_row = -1;
#pragma unroll
    for (int j = 0; j < 4; ++j) { cgp[j] = Y ? *(const f32x4*)(gpost + lo + 256 * j) : (f32x4){0.f, 0.f, 0.f, 0.f}; cgr[j] = gpre ? *(const f32x4*)(gpre + lo + 256 * j) : (f32x4){0.f, 0.f, 0.f, 0.f}; }
    for (int row0 = rbeg;; row0 += 2) {
        if (!ctxmode && row0 >= rend) ctxmode = true;
        if (ctxmode) { if (crow >= nrows) break; row0 = crow; crow += NGW; }
        const bool has1 = !ctxmode && (row0 + 1 < rend) && (((row0 + 1) >> 12) == (row0 >> 12));
        const int bi = (row0 < MLAT) ? (row0 >> 12) : 8;
        if (bi != cur_bi) {
            cur_bi = bi;
            const float* gate = MOD + (size_t)(mli * 9 + bi) * 9216 + (mj * 3 + 2) * 1024;
            const float* sh = MOD + (size_t)(nli * 9 + bi) * 9216 + (nj * 3 + 0) * 1024;
#pragma unroll
            for (int j = 0; j < 4; ++j) {
                if (Y) pg[j] = *(const f32x4*)(gate + lo + 256 * j) * cgp[j] * wgt;
                if (gpre) { ps1[j] = (*(const f32x4*)(sh + 1024 + lo + 256 * j) + 1.0f) * cgr[j]; ps0[j] = *(const f32x4*)(sh + lo + 256 * j); }
            }
        }
        const int rows[2] = {row0, has1 ? row0 + 1 : row0};
        f32x4 x[2][4], y[2][4];
        const bool regular = !init && !ctxmode && has1 && (Y != nullptr);
        if (regular) {
            u32x2 cx[2][4], cy[2][4];
            if (pf_row == row0) {
#pragma unroll
                for (int q = 0; q < 2; ++q)
#pragma unroll
                    for (int j = 0; j < 4; ++j) { cx[q][j] = pxr[q][j]; cy[q][j] = pyr[q][j]; }
            } else {
#pragma unroll
                for (int q = 0; q < 2; ++q)
#pragma unroll
                    for (int j = 0; j < 4; ++j) { cx[q][j] = *(const u32x2*)(X + (size_t)(row0 + q) * D + lo + 256 * j); cy[q][j] = *(const u32x2*)(Y + (size_t)(row0 + q) * D + lo + 256 * j); }
            }
            const int nr = row0 + 2;
            if (nr + 1 < rend && (((nr + 1) >> 12) == (row0 >> 12))) {
#pragma unroll
                for (int q = 0; q < 2; ++q)
#pragma unroll
                    for (int j = 0; j < 4; ++j) { pxr[q][j] = *(const u32x2*)(X + (size_t)(nr + q) * D + lo + 256 * j); pyr[q][j] = *(const u32x2*)(Y + (size_t)(nr + q) * D + lo + 256 * j); }
                pf_row = nr;
            } else pf_row = -1;
#pragma unroll
            for (int q = 0; q < 2; ++q)
#pragma unroll
                for (int j = 0; j < 4; ++j) {
                    x[q][j] = __builtin_convertvector(__builtin_bit_cast(h16x4, cx[q][j]), f32x4);
                    y[q][j] = (f32x4){bflo(cy[q][j].x), bfhi(cy[q][j].x), bflo(cy[q][j].y), bfhi(cy[q][j].y)};
                }
        } else
#pragma unroll
        for (int q = 0; q < 2; ++q) {
            const int row = rows[q];
            if (init) {
                const float* src = (row < MLAT) ? INP(0) + (size_t)row * D : INP(2) + (size_t)(row - MLAT) * D;
#pragma unroll
                for (int j = 0; j < 4; ++j) x[q][j] = *(const f32x4*)(src + lo + 256 * j);
            } else {
#pragma unroll
                for (int j = 0; j < 4; ++j) x[q][j] = __builtin_convertvector(*(const h16x4*)(X + (size_t)row * D + lo + 256 * j), f32x4);
            }
            if (Y) {
                if (ysplit > 0 && row >= MLAT) {
                    const bf16* yp = (const bf16*)(F.ws + WS_E) + (size_t)(row - MLAT) * D + lo;
#pragma unroll
                    for (int j = 0; j < 4; ++j) y[q][j] = (f32x4){0.f, 0.f, 0.f, 0.f};
                    for (int p0 = 0; p0 < ysplit; p0 += 4) {
                        u32x2 w[4][4];
#pragma unroll
                        for (int pp = 0; pp < 4; ++pp) { const int p = (p0 + pp < ysplit) ? p0 + pp : p0;
#pragma unroll
                            for (int j = 0; j < 4; ++j) w[pp][j] = *(const u32x2*)(yp + (size_t)p * 2048 * D + 256 * j); }
#pragma unroll
                        for (int pp = 0; pp < 4; ++pp) if (p0 + pp < ysplit) {
#pragma unroll
                            for (int j = 0; j < 4; ++j) y[q][j] = y[q][j] + (f32x4){bflo(w[pp][j].x), bfhi(w[pp][j].x), bflo(w[pp][j].y), bfhi(w[pp][j].y)}; }
                    }
                } else {
#pragma unroll
                    for (int j = 0; j < 4; ++j) { const u32x2 w = *(const u32x2*)(Y + (size_t)row * D + lo + 256 * j); y[q][j] = (f32x4){bflo(w.x), bfhi(w.x), bflo(w.y), bfhi(w.y)}; }
                }
            }
        }
        if (Y) {
            float ss[2];
#pragma unroll
            for (int q = 0; q < 2; ++q) { ss[q] = 0.f;
#pragma unroll
                for (int j = 0; j < 4; ++j) ss[q] += y[q][j][0] * y[q][j][0] + y[q][j][1] * y[q][j][1] + y[q][j][2] * y[q][j][2] + y[q][j][3] * y[q][j][3]; }
#pragma unroll
            for (int o = 1; o < 64; o <<= 1) { ss[0] += __shfl_xor(ss[0], o); ss[1] += __shfl_xor(ss[1], o); }
#pragma unroll
            for (int q = 0; q < 2; ++q) {
                const float rstd = rsqrtf(ss[q] * (1.0f / D) + RMS_EPS);
#pragma unroll
                for (int j = 0; j < 4; ++j) x[q][j] = x[q][j] + pg[j] * y[q][j] * rstd;
            }
        }
#pragma unroll
        for (int q = 0; q < 2; ++q) {
            if (q == 1 && !has1) break;
            if (fin) {
#pragma unroll
                for (int j = 0; j < 4; ++j) *(f32x4*)((float*)F.out + (size_t)rows[q] * D + lo + 256 * j) = x[q][j];
            } else {
#pragma unroll
                for (int j = 0; j < 4; ++j) *(h16x4*)(X + (size_t)rows[q] * D + lo + 256 * j) = __builtin_convertvector(x[q][j], h16x4);
            }
        }
        if (gpre) {
            float ss[2];
#pragma unroll
            for (int q = 0; q < 2; ++q) { ss[q] = 0.f;
#pragma unroll
                for (int j = 0; j < 4; ++j) ss[q] += x[q][j][0] * x[q][j][0] + x[q][j][1] * x[q][j][1] + x[q][j][2] * x[q][j][2] + x[q][j][3] * x[q][j][3]; }
#pragma unroll
            for (int o = 1; o < 64; o <<= 1) { ss[0] += __shfl_xor(ss[0], o); ss[1] += __shfl_xor(ss[1], o); }
#pragma unroll
            for (int q = 0; q < 2; ++q) {
                if (q == 1 && !has1) break;
                const float rstd = rsqrtf(ss[q] * (1.0f / D) + RMS_EPS);
#pragma unroll
                for (int j = 0; j < 4; ++j) {
                    const f32x4 h = x[q][j] * rstd * ps1[j] + ps0[j];
                    u32x2 w; w.x = pk2(h[0], h[1]); w.y = pk2(h[2], h[3]);
                    *(u32x2*)(H + (size_t)rows[q] * D + lo + 256 * j) = w; }
            }
        }
        if (!ctxmode && !has1 && row0 + 1 < rend) row0 -= 1;
    }
}

__device__ __forceinline__ float xhalf(float v, int owner) {
    const auto rr = __builtin_amdgcn_permlane32_swap(__float_as_uint(v), __float_as_uint(v), false, false);
    return __uint_as_float(owner ? rr[1] : rr[0]);
}
__device__ __forceinline__ int s5_row(int b, int dir, int jj) {
    if (jj < 256) return MLAT + b * 256 + (dir ? 255 - jj : jj);
    const int t = jj - 256; return b * 4096 + (dir ? 4095 - t : t);
}
template <bool OUTPUT>
__device__ __forceinline__ void s5_pass(Frame& F) {
    const bf16* H = (const bf16*)(F.ws + WS_H);
    const float* LAM = (const float*)(F.ws + WS_S5LAM); const bf16x8* BMv = (const bf16x8*)(F.ws + WS_S5B); const bf16x8* CMv = (const bf16x8*)(F.ws + WS_S5C);
    float* EST = (float*)(F.ws + WS_U + 2 * ACT_BYTES);
    bf16* Y0 = (bf16*)(F.ws + WS_U); bf16* Y1 = (bf16*)(F.ws + WS_U + ACT_BYTES);
    const int lane = F.lane, pc = lane & 31, hi = lane >> 5;
    LAS unsigned* hm = (LAS unsigned*)(F.lds + F.wave * 8704);
    for (int bu = F.bid; bu < 8 * 2 * 17 * 8; bu += F.G) {
        const int g = 8 * (bu & 7) + F.wave; const int sc = (bu >> 3) % 17; const int bd = (bu >> 3) / 17; const int dir = bd & 1, b = bd >> 1;
        const int dg = dir * 64 + g;
        bf16x8 bfr[4], cfr[4];
#pragma unroll
        for (int q = 0; q < 4; ++q) { bfr[q] = BMv[(dg * 4 + q) * 64 + lane]; if (OUTPUT) cfr[q] = CMv[(dg * 4 + q) * 64 + lane]; }
        const float l0r = LAM[(dg * 64 + pc) * 2], l0i = LAM[(dg * 64 + pc) * 2 + 1], l1r = LAM[(dg * 64 + pc + 32) * 2], l1i = LAM[(dg * 64 + pc + 32) * 2 + 1];
        float h0r = 0.f, h0i = 0.f, h1r = 0.f, h1i = 0.f;
        const size_t ebase = (((size_t)(b * 2 + dir) * 17) * 64 + g) * 128;
        if (OUTPUT) {
            float p0r = l0r, p0i = l0i, p1r = l1r, p1i = l1i;
#pragma unroll
            for (int q = 0; q < 8; ++q) { float t = p0r * p0r - p0i * p0i; p0i = 2.f * p0r * p0i; p0r = t; t = p1r * p1r - p1i * p1i; p1i = 2.f * p1r * p1i; p1r = t; }
            for (int c = 0; c < sc; ++c) {
                const float* e = EST + ebase + (size_t)c * 64 * 128;
                const float e0r = e[pc * 2], e0i = e[pc * 2 + 1], e1r = e[(pc + 32) * 2], e1i = e[(pc + 32) * 2 + 1];
                float t = p0r * h0r - p0i * h0i + e0r; h0i = p0r * h0i + p0i * h0r + e0i; h0r = t;
                t = p1r * h1r - p1i * h1i + e1r; h1i = p1r * h1i + p1i * h1r + e1i; h1r = t;
            }
        }
        bf16x8 ua_next = *(const bf16x8*)(H + (size_t)s5_row(b, dir, sc * 256 + pc) * D + g * 16 + 8 * hi);
        for (int sub = 0; sub < 8; ++sub) {
            const int j0 = sc * 256 + sub * 32;
            const bf16x8 ua = ua_next;
            if (sub + 1 < 8) ua_next = *(const bf16x8*)(H + (size_t)s5_row(b, dir, j0 + 32 + pc) * D + g * 16 + 8 * hi);
            f32x16 d0 = {}, d1 = {}, d2 = {}, d3 = {};
            d0 = MFMA32(ua, bfr[0], d0); d1 = MFMA32(ua, bfr[1], d1); d2 = MFMA32(ua, bfr[2], d2); d3 = MFMA32(ua, bfr[3], d3);
#pragma unroll
            for (int run = 0; run < 8; ++run) {
                const int owner = run & 1, rb = 4 * (run >> 1);
#pragma unroll
                for (int i = 0; i < 4; ++i) {
                    const int r = rb + i;
                    float t = l0r * h0r - l0i * h0i + d0[r]; h0i = l0r * h0i + l0i * h0r + d1[r]; h0r = t;
                    t = l1r * h1r - l1i * h1i + d2[r]; h1i = l1r * h1i + l1i * h1r + d3[r]; h1r = t;
                    if (OUTPUT) { if (hi == owner) { const int s = 4 * run + i; hm[s * 68 + pc] = pk2(h0r, h0i); hm[s * 68 + pc + 32] = pk2(h1r, h1i); } }
                }
                h0r = xhalf(h0r, owner); h0i = xhalf(h0i, owner); h1r = xhalf(h1r, owner); h1i = xhalf(h1i, owner);
            }
            if (OUTPUT) {
                __syncthreads();
                bf16* Yd = dir ? Y1 : Y0;
#pragma unroll
                for (int st = 0; st < 2; ++st) {
                    f32x4 acc = {0.f, 0.f, 0.f, 0.f};
                    const int s = 16 * st + (lane & 15);
#pragma unroll
                    for (int kc = 0; kc < 4; ++kc) { const bf16x8 hb = *(const LAS bf16x8*)(hm + s * 68 + 16 * kc + 4 * (lane >> 4)); acc = MFMA16(cfr[kc], hb, acc); }
                    u32x2 w; w.x = pk2(acc[0], acc[1]); w.y = pk2(acc[2], acc[3]);
                    *(u32x2*)(Yd + (size_t)s5_row(b, dir, j0 + s) * D + g * 16 + 4 * (lane >> 4)) = w;
                }
                __syncthreads();
            }
        }
        if (!OUTPUT) {
            if (hi == 0) { float* e = EST + ebase + (size_t)sc * 64 * 128; e[pc * 2] = h0r; e[pc * 2 + 1] = h0i; e[(pc + 32) * 2] = h1r; e[(pc + 32) * 2 + 1] = h1i; }
        }
    }
}
__device__ __forceinline__ void s5_z_phase(Frame& F) {
    bf16* H = (bf16*)(F.ws + WS_H); const bf16* Y0 = (const bf16*)(F.ws + WS_U); const bf16* Y1 = (const bf16*)(F.ws + WS_U + ACT_BYTES);
    const float* dsk = INP(18);
    const size_t n8 = (size_t)MALL * D / 8;
    for (size_t i = (size_t)F.bid * NTHREADS + F.tid; i < n8; i += (size_t)F.G * NTHREADS) {
        const u32x4 h = *(const u32x4*)(H + i * 8), a = *(const u32x4*)(Y0 + i * 8), c = *(const u32x4*)(Y1 + i * 8);
        const int col = (int)((i * 8) & 1023);
        const f32x4 dA = *(const f32x4*)(dsk + col), dB = *(const f32x4*)(dsk + col + 4);
        const unsigned hh[4] = {h.x, h.y, h.z, h.w}, aa[4] = {a.x, a.y, a.z, a.w}, cc[4] = {c.x, c.y, c.z, c.w};
        unsigned o[4];
#pragma unroll
        for (int j = 0; j < 4; ++j) {
            const float dl = (j < 2) ? dA[2 * j] : dB[2 * j - 4], dh = (j < 2) ? dA[2 * j + 1] : dB[2 * j - 3];
            const float yl = dl * bflo(hh[j]) + bflo(aa[j]) + bflo(cc[j]), yh = dh * bfhi(hh[j]) + bfhi(aa[j]) + bfhi(cc[j]);
            const float zl = yl * fsigmoid(1.5957691216057308f * (yl + 0.044715f * yl * yl * yl)), zh = yh * fsigmoid(1.5957691216057308f * (yh + 0.044715f * yh * yh * yh));
            o[j] = pk2(zl, zh);
        }
        *(u32x4*)(H + i * 8) = (u32x4){o[0], o[1], o[2], o[3]};
    }
}

template <int NDB>
__device__ __forceinline__ void flash_pv(const LAS unsigned char* vs, int r32, int hi, const bf16x8 (&pw)[4], f32x16 (&o)[NDB]) {
    const LAS unsigned char* vrow = vs + r32 * 144 + hi * 16;
#pragma unroll
    for (int d2 = 0; d2 < NDB; d2 += 2) {
        bf16x8 vf[2][4];
#pragma unroll
        for (int db = 0; db < 2; ++db)
#pragma unroll
            for (int q = 0; q < 4; ++q) vf[db][q] = *(const LAS bf16x8*)(vrow + (d2 + db) * 32 * 144 + q * 32);
        __builtin_amdgcn_sched_barrier(0);
#pragma unroll
        for (int q = 0; q < 4; ++q)
#pragma unroll
            for (int db = 0; db < 2; ++db) o[d2 + db] = MFMA32(vf[db][q], pw[q], o[d2 + db]);
        __builtin_amdgcn_sched_barrier(0);
    }
}
template <int DV, bool NA>
__device__ __forceinline__ void flash_pass(Frame& F, const bf16* Qw  , const bf16* Kb, const bf16* Vtb, int ta1, int tb0, int tb1,
                                           int rq, int qc, f32x16 (&o)[DV / 32]) {
    constexpr bool na = NA;
    constexpr int NDB = DV / 32, KS_B = 64 * 72 * 2, VS_B = DV * 72 * 2, VOFF = 2 * KS_B, BOFF = VOFF + 3 * VS_B;
    constexpr int NVL = DV / 64;
    const int tid = F.tid, lane = F.lane, r32 = lane & 31, hi = lane >> 5;
    const bool grpB = (F.wave & 1);
    const LAS float* bias = (const LAS float*)(F.lds + BOFF);
    bf16x8 qr[4];
#pragma unroll
    for (int d0 = 0; d0 < 4; ++d0) qr[d0] = *(const bf16x8*)(Qw + (size_t)r32 * 64 + d0 * 16 + hi * 8);
#pragma unroll
    for (int db = 0; db < NDB; ++db) o[db] = (f32x16){};
    float mrun = -3.0e38f, lrun = 0.f;
    const int nt = ta1 + (tb1 - tb0);
    const int krow = tid >> 3, kch = tid & 7;
    u32x4 kregA, kregB; u32x4 vregA[NVL], vregB[NVL];
    bf16x8 pw[4]; bool havePV = false; int pvb = 0;
#define FL_VDST(vbuf, idx) (F.lds + VOFF + (vbuf) * VS_B + ((idx) >> 3) * 144 + (((idx) & 7) >> 1) * 32 + ((idx) & 1) * 8)
#define FL_TILE(i) (((i) < ta1) ? (i) : tb0 + ((i) - ta1))
#define FL_LOAD(KR, VR, i) do { const int tl_ = FL_TILE(i); KR = *(const u32x4*)(Kb + ((size_t)tl_ * 64 + krow) * 64 + kch * 8); \
        _Pragma("unroll") for (int i_ = 0; i_ < NVL; ++i_) { const int idx = tid + 512 * i_; VR[i_] = *(const u32x4*)(Vtb + (size_t)(idx >> 3) * TALL + tl_ * 64 + (idx & 7) * 8); } } while (0)
#define FL_STORE(KR, VR, kbuf, vbuf) do { *(LAS u32x4*)(F.lds + (kbuf) * KS_B + krow * 144 + kch * 16) = KR; \
        _Pragma("unroll") for (int i_ = 0; i_ < NVL; ++i_) { const int idx = tid + 512 * i_; LAS unsigned char* p = FL_VDST(vbuf, idx); *(LAS u32x2*)p = (u32x2){VR[i_].x, VR[i_].y}; *(LAS u32x2*)(p + 16) = (u32x2){VR[i_].z, VR[i_].w}; } } while (0)
    FL_LOAD(kregA, vregA, 0); FL_STORE(kregA, vregA, 0, 0);
    if (1 < nt) FL_LOAD(kregA, vregA, 1);
    if (2 < nt) FL_LOAD(kregB, vregB, 2);
    __syncthreads();
    int vb = 0;
    auto step = [&](const int it, u32x4& kregX, u32x4 (&vregX)[NVL]) {
        const int buf = it & 1;
        const int tile = FL_TILE(it);
        const bool more = (it + 1 < nt);
        if (havePV) { flash_pv<NDB>(F.lds + VOFF + pvb * VS_B, r32, hi, pw, o); havePV = false; }
        bool active = true; int kr = 0;
        if (na && tile >= 4) { kr = tile - 4; int r0 = rq - 4; r0 = r0 < 0 ? 0 : (r0 > 56 ? 56 : r0); active = (kr >= r0) && (kr < r0 + 8); }
        if (active) {
            const LAS unsigned char* ks = F.lds + buf * KS_B;
            f32x16 p0 = {}, p1 = {};
            {
                bf16x8 kf[8];
#pragma unroll
                for (int d0 = 0; d0 < 4; ++d0) { kf[2 * d0] = *(const LAS bf16x8*)(ks + r32 * 144 + d0 * 32 + hi * 16); kf[2 * d0 + 1] = *(const LAS bf16x8*)(ks + (32 + r32) * 144 + d0 * 32 + hi * 16); }
                __builtin_amdgcn_sched_barrier(0);
#pragma unroll
                for (int d0 = 0; d0 < 4; ++d0) { p0 = MFMA32(kf[2 * d0], qr[d0], p0); p1 = MFMA32(kf[2 * d0 + 1], qr[d0], p1); }
            }
            if (na && tile >= 4) {
                int c0 = qc - 8; c0 = c0 < 0 ? 0 : (c0 > 48 ? 48 : c0);
                const int brow = (kr - rq + 7) * 31 + 15 - qc;
#pragma unroll
                for (int r = 0; r < 16; ++r) {
                    const int kc0 = crow(r, hi), kc1 = 32 + kc0;
                    const bool v0 = (kc0 >= c0) && (kc0 < c0 + 16), v1 = (kc1 >= c0) && (kc1 < c0 + 16);
                    p0[r] = v0 ? p0[r] + bias[brow + kc0] : -1.0e30f;
                    p1[r] = v1 ? p1[r] + bias[brow + kc1] : -1.0e30f;
                }
            }
            float mx;
            { float t[16];
#pragma unroll
              for (int r = 0; r < 16; ++r) t[r] = fmaxf(p0[r], p1[r]);
#pragma unroll
              for (int w_ = 8; w_ >= 1; w_ >>= 1)
#pragma unroll
                  for (int r = 0; r < w_; ++r) t[r] = fmaxf(t[r], t[r + w_]);
              mx = t[0]; }
            mx = fmaxf(mx, __shfl_xor(mx, 32));
            if (__any(mx > mrun + 8.0f)) {
                const float mnew = fmaxf(mrun, mx);
                const float alpha = __builtin_amdgcn_exp2f(mrun - mnew);
                mrun = mnew; lrun *= alpha;
#pragma unroll
                for (int db = 0; db < NDB; ++db)
#pragma unroll
                    for (int r = 0; r < 16; ++r) o[db][r] *= alpha;
            }
            { float t[16];
#pragma unroll
              for (int r = 0; r < 16; ++r) { p0[r] = __builtin_amdgcn_exp2f(p0[r] - mrun); p1[r] = __builtin_amdgcn_exp2f(p1[r] - mrun); t[r] = p0[r] + p1[r]; }
#pragma unroll
              for (int w_ = 8; w_ >= 1; w_ >>= 1)
#pragma unroll
                  for (int r = 0; r < w_; ++r) t[r] += t[r + w_];
              lrun += t[0]; }
#pragma unroll
            for (int q = 0; q < 4; ++q) {
                u32x4 w;
                if (q < 2) { w.x = pk2(p0[8 * q + 0], p0[8 * q + 1]); w.y = pk2(p0[8 * q + 2], p0[8 * q + 3]); w.z = pk2(p0[8 * q + 4], p0[8 * q + 5]); w.w = pk2(p0[8 * q + 6], p0[8 * q + 7]); }
                else { const int qq = q - 2; w.x = pk2(p1[8 * qq + 0], p1[8 * qq + 1]); w.y = pk2(p1[8 * qq + 2], p1[8 * qq + 3]); w.z = pk2(p1[8 * qq + 4], p1[8 * qq + 5]); w.w = pk2(p1[8 * qq + 6], p1[8 * qq + 7]); }
                pw[q] = __builtin_bit_cast(bf16x8, w);
            }
            if (grpB) { havePV = true; pvb = vb; }
            else flash_pv<NDB>(F.lds + VOFF + vb * VS_B, r32, hi, pw, o);
        }
        const int vnext = (vb == 2) ? 0 : vb + 1;
        if (more) {
            FL_STORE(kregX, vregX, buf ^ 1, vnext);
            if (it + 3 < nt) FL_LOAD(kregX, vregX, it + 3);
        }
        vb = vnext;
        __syncthreads();
    };
    for (int it = 0; it < nt; it += 2) {
        step(it, kregA, vregA);
        if (it + 1 < nt) step(it + 1, kregB, vregB);
    }
    if (havePV) flash_pv<NDB>(F.lds + VOFF + pvb * VS_B, r32, hi, pw, o);
    __syncthreads();
#undef FL_VDST
#undef FL_TILE
#undef FL_LOAD
#undef FL_STORE
    lrun += __shfl_xor(lrun, 32);
    const float rl = 1.0f / lrun;
#pragma unroll
    for (int db = 0; db < NDB; ++db)
#pragma unroll
        for (int r = 0; r < 16; ++r) o[db][r] *= rl;
}

__device__ __forceinline__ void att_da_phase(Frame& F) {
    const bf16* Q = (const bf16*)(F.ws + WS_U); const bf16* K = (const bf16*)(F.ws + WS_U + ACT_BYTES); const bf16* Vt = (const bf16*)(F.ws + WS_U + 2 * ACT_BYTES);
    bf16* OA = (bf16*)(F.ws + WS_H);
    float* stash = (float*)(F.ws + WS_E) + (size_t)F.bid * (8 * 64 * 64) + F.wave * (64 * 64);
    float s1 = 0.f, s2 = 0.f;
    for (int i = 0; i < 64; ++i) { s1 += INP(23)[i] * INP(24)[i]; s2 += INP(25)[i] * INP(26)[i]; }
    const float lam_init = 0.8f - 0.6f * expf(-0.3f * 1.0f);
    const float lam = expf(s1) - expf(s2) + lam_init;
    const int lane = F.lane, r32 = lane & 31, hi = lane >> 5;
    const int vcu = (F.G % 8 == 0) ? (F.bid % 8) * (F.G / 8) + F.bid / 8 : F.bid;
    for (int u = vcu; u < 8 * 8 * 17; u += F.G) {
        int b, h, qb;
        if (u < 1024) { b = u >> 7; h = (u >> 4) & 7; qb = 1 + (u & 15); } else { const int v = u - 1024; b = v >> 3; h = v & 7; qb = 0; }
        const int s0 = 256 * qb + 32 * F.wave;
        const int nta = qb ? 68 : 4;
        f32x16 o[4];
#pragma unroll 1
        for (int m = 0; m < 2; ++m) {
            const int hm = 2 * h + m;
            flash_pass<128, false>(F, Q + ((size_t)(b * 16 + hm) * TALL + s0) * 64, K + (size_t)(b * 16 + hm) * TALL * 64, Vt + (size_t)(b * 8 + h) * 128 * TALL, nta, 0, 0, 0, 0, o);
            if (m == 0) {
                GAS float* sp = (GAS float*)(stash + lane); asm volatile("" : "+v"(sp));
#pragma unroll
                for (int db = 0; db < 4; ++db)
#pragma unroll
                    for (int r = 0; r < 16; ++r) sp[(db * 16 + r) * 64] = o[db][r];
            }
        }
        float ss = 0.f;
        {
            const GAS float* sp = (const GAS float*)(stash + lane); asm volatile("" : "+v"(sp));
#pragma unroll
            for (int db = 0; db < 4; ++db) {
#pragma unroll
                for (int r = 0; r < 16; ++r) { const float a = sp[(db * 16 + r) * 64] - lam * o[db][r]; o[db][r] = a; ss += a * a; }
                asm volatile("" ::: "memory");
            }
        }
        ss += __shfl_xor(ss, 32);
        const float rstd = rsqrtf(ss * (1.0f / 128.0f) + RMS_EPS) * (1.0f - lam_init);
        const int s = s0 + r32;
        const size_t row = qb ? (size_t)b * 4096 + (s - 256) : (size_t)MLAT + b * 256 + s;
        GAS bf16* op = (GAS bf16*)(OA + row * D + h * 128 + 4 * hi); asm volatile("" : "+v"(op));
        const GAS float* gp = (const GAS float*)(INP(27) + 4 * hi); asm volatile("" : "+v"(gp));
#pragma unroll
        for (int db = 0; db < 4; ++db)
#pragma unroll
            for (int rg = 0; rg < 4; ++rg) {
                const int d = 32 * db + 8 * rg;
                const f32x4 g = *(const GAS f32x4*)(gp + d);
                u32x2 w; w.x = pk2(o[db][4 * rg] * rstd * g[0], o[db][4 * rg + 1] * rstd * g[1]); w.y = pk2(o[db][4 * rg + 2] * rstd * g[2], o[db][4 * rg + 3] * rstd * g[3]);
                *(GAS u32x2*)(op + d) = w;
            }
    }
}
__device__ __forceinline__ void att_na_phase(Frame& F) {
    const bf16* Q = (const bf16*)(F.ws + WS_U); const bf16* K = (const bf16*)(F.ws + WS_U + ACT_BYTES); const bf16* Vt = (const bf16*)(F.ws + WS_U + 2 * ACT_BYTES);
    bf16* OA = (bf16*)(F.ws + WS_H);
    constexpr int BOFF = 2 * 64 * 72 * 2 + 3 * 64 * 72 * 2;
    LAS float* bias = (LAS float*)(F.lds + BOFF);
    const int lane = F.lane, r32 = lane & 31, hi = lane >> 5;
    const int vcu = (F.G % 8 == 0) ? (F.bid % 8) * (F.G / 8) + F.bid / 8 : F.bid;
    for (int u = vcu; u < 8 * 16 * 17; u += F.G) {
        int b, h, R4; bool lat;
        if (u < 2048) { b = u >> 8; h = (u >> 4) & 15; R4 = u & 15; lat = true; } else { const int v = u - 2048; b = v >> 4; h = v & 15; R4 = 0; lat = false; }
        if (lat) { for (int i = F.tid; i < 15 * 31; i += NTHREADS) bias[i] = INP(30)[h * 465 + i] * LOG2E; }
        const int s0 = (lat ? 256 + 256 * R4 : 0) + 32 * F.wave;
        int lo = 4 * R4 - 4; lo = lo < 0 ? 0 : (lo > 56 ? 56 : lo);
        int hh = 4 * R4 + 3 - 4; hh = hh < 0 ? 0 : (hh > 56 ? 56 : hh); hh += 8;
        f32x16 o[2];
        if (lat) flash_pass<64, true>(F, Q + ((size_t)(b * 16 + h) * TALL + s0) * 64, K + (size_t)(b * 16 + h) * TALL * 64, Vt + (size_t)(b * 16 + h) * 64 * TALL, 4, 4 + lo, 4 + hh, 4 * R4 + (F.wave >> 1), 32 * (F.wave & 1) + r32, o);
        else flash_pass<64, false>(F, Q + ((size_t)(b * 16 + h) * TALL + s0) * 64, K + (size_t)(b * 16 + h) * TALL * 64, Vt + (size_t)(b * 16 + h) * 64 * TALL, 4, 0, 0, 0, 0, o);
        const int s = s0 + r32;
        const size_t row = lat ? (size_t)b * 4096 + (s - 256) : (size_t)MLAT + b * 256 + s;
        GAS bf16* op = (GAS bf16*)(OA + row * D + h * 64 + 4 * hi); asm volatile("" : "+v"(op));
#pragma unroll
        for (int db = 0; db < 2; ++db)
#pragma unroll
            for (int rg = 0; rg < 4; ++rg) {
                const int d = 32 * db + 8 * rg;
                u32x2 w; w.x = pk2(o[db][4 * rg], o[db][4 * rg + 1]); w.y = pk2(o[db][4 * rg + 2], o[db][4 * rg + 3]);
                *(GAS u32x2*)(op + d) = w;
            }
    }
}

__device__ __forceinline__ bf16* hg_o1_row(Frame& F, int row) {
    return (bf16*)(F.ws + WS_U + 4 * ACT_BYTES) + (size_t)row * D;
}
__device__ __forceinline__ void gla_phase(Frame& F) {
    const bf16* Qb = (const bf16*)(F.ws + WS_U); const bf16* Ib = (const bf16*)(F.ws + WS_U + ACT_BYTES);
    const bf16* Z0 = (const bf16*)F.out; const bf16* Z1 = (const bf16*)(F.ws + WS_U + 3 * ACT_BYTES);
    bf16* O0 = (bf16*)(F.ws + WS_H);
    constexpr int QD = 0, KI = 17408, KDT = 34816, VT = 53248, ST = 62464, ATT = 79872, GL = 89088, TOT = 89600;
    constexpr int ZS = 91648, QS = ZS + 17408, VS2 = QS + 17408;
    const int tid = F.tid, lane = F.lane, w = F.wave, r32 = lane & 31, hi = lane >> 5;
    const int kcol = tid & 127, tq = tid >> 7, vcol = tid & 63, tv = tid >> 6;
    for (int u = F.bid; u < 256; u += F.G) {
        const int b = u >> 5, h = (u >> 2) & 7, dir = (u >> 1) & 1, vh = u & 1;
        const bf16* Zd = dir ? Z1 : Z0;
        float lbk;
        { const int c = h * 128 + kcol; const float a0 = INP(34)[c], a1 = INP(34)[1024 + c], a2 = INP(34)[2048 + c], a3 = INP(34)[3072 + c];
          const float mx = fmaxf(fmaxf(a0, a1), fmaxf(a2, a3)); const float e0 = expf(a0 - mx), e1 = expf(a1 - mx), e2 = expf(a2 - mx), e3 = expf(a3 - mx);
          lbk = (e1 + e2 + e3) / (e0 + e1 + e2 + e3); }
        const float omlb = 1.0f - lbk;
        f32x16 S = {};
        for (int i = tid; i < 17408 / 4; i += NTHREADS) ((LAS unsigned*)(F.lds + ST))[i] = 0u;
        const int kb = w >> 1, vb = w & 1;
        u32x4 zreg[2], qreg[2], vreg;
        const int sj0 = tid >> 4, sc0 = (tid & 15) * 8;
        const int vj = tid >> 3, vc = (tid & 7) * 8;
#define GLA_ROW(c, j) ((c) < 4 ? (MLAT + b * 256 + (dir ? 255 - (64 * (c) + (j)) : 64 * (c) + (j))) : (b * 4096 + (dir ? 4095 - (64 * ((c) - 4) + (j)) : 64 * ((c) - 4) + (j))))
#define GLA_LOAD(c) do { _Pragma("unroll") for (int i = 0; i < 2; ++i) { const size_t ro = (size_t)GLA_ROW(c, sj0 + 32 * i) * D + h * 128 + sc0; zreg[i] = *(const u32x4*)(Zd + ro); qreg[i] = *(const u32x4*)(Qb + ro); } \
        vreg = *(const u32x4*)(Ib + (size_t)GLA_ROW(c, vj) * D + h * 128 + vh * 64 + vc); } while (0)
#define GLA_PARK() do { _Pragma("unroll") for (int i = 0; i < 2; ++i) { *(LAS u32x4*)(F.lds + ZS + (sj0 + 32 * i) * 272 + sc0 * 2) = zreg[i]; *(LAS u32x4*)(F.lds + QS + (sj0 + 32 * i) * 272 + sc0 * 2) = qreg[i]; } \
        *(LAS u32x4*)(F.lds + VS2 + vj * 144 + vc * 2) = vreg; } while (0)
        GLA_LOAD(0); GLA_PARK(); GLA_LOAD(1);
        __syncthreads();
        for (int c = 0; c < 68; ++c) {
            float g[16], kk[16], run = 0.f;
#pragma unroll
            for (int i = 0; i < 16; ++i) { const float sg = fsigmoid(bf2f(((const LAS bf16*)(F.lds + ZS))[(16 * tq + i) * 136 + kcol])); const float f = lbk + omlb * sg; run += __logf(f); g[i] = run; kk[i] = omlb * (1.0f - sg); }
            ((LAS float*)(F.lds + TOT))[tq * 128 + kcol] = run;
            __syncthreads();
            float pre = 0.f, gl = 0.f;
#pragma unroll
            for (int q = 0; q < 4; ++q) { const float t = ((LAS float*)(F.lds + TOT))[q * 128 + kcol]; gl += t; if (q < tq) pre += t; }
            const float egl = fexp(gl);
            unsigned kdp[8];
#pragma unroll
            for (int i = 0; i < 16; i += 2) {
                const float g0 = g[i] + pre, g1 = g[i + 1] + pre;
                const float e0 = fexp(g0), e1 = fexp(g1);
                const float ie0 = __builtin_amdgcn_rcpf(e0), ie1 = __builtin_amdgcn_rcpf(e1);
                const int j0 = 16 * tq + i;
                const float q0 = bf2f(((const LAS bf16*)(F.lds + QS))[j0 * 136 + kcol]), q1 = bf2f(((const LAS bf16*)(F.lds + QS))[(j0 + 1) * 136 + kcol]);
                ((LAS bf16*)(F.lds + QD))[j0 * 136 + kcol] = (bf16)f2bf(q0 * e0); ((LAS bf16*)(F.lds + QD))[(j0 + 1) * 136 + kcol] = (bf16)f2bf(q1 * e1);
                ((LAS bf16*)(F.lds + KI))[j0 * 136 + kcol] = (bf16)f2bf(kk[i] * ie0); ((LAS bf16*)(F.lds + KI))[(j0 + 1) * 136 + kcol] = (bf16)f2bf(kk[i + 1] * ie1);
                kdp[i >> 1] = pk2(kk[i] * egl * ie0, kk[i + 1] * egl * ie1);
            }
            { LAS u32x4* p = (LAS u32x4*)(F.lds + KDT + kcol * 144 + tq * 32); p[0] = (u32x4){kdp[0], kdp[1], kdp[2], kdp[3]}; p[1] = (u32x4){kdp[4], kdp[5], kdp[6], kdp[7]}; }
            if (tq == 0) ((LAS float*)(F.lds + GL))[kcol] = egl;
            { unsigned short vr[8];
#pragma unroll
              for (int i = 0; i < 8; ++i) vr[i] = ((const LAS bf16*)(F.lds + VS2))[(8 * tv + i) * 72 + vcol];
              LAS u32x4* p = (LAS u32x4*)(F.lds + VT + vcol * 144 + tv * 16);
              p[0] = (u32x4){(unsigned)vr[0] | ((unsigned)vr[1] << 16), (unsigned)vr[2] | ((unsigned)vr[3] << 16), (unsigned)vr[4] | ((unsigned)vr[5] << 16), (unsigned)vr[6] | ((unsigned)vr[7] << 16)}; }
            __syncthreads();
            f32x16 oacc = {};
            const int tb = (w - 4) >> 1, ovb = (w - 4) & 1;
            if (c >= 4) {
                if (w < 3) {
                    const int atb = (w >= 1), asb = (w == 2);
                    f32x16 a = {};
#pragma unroll
                    for (int q = 0; q < 8; ++q) {
                        const bf16x8 fa = *(const LAS bf16x8*)(F.lds + QD + (32 * atb + r32) * 272 + q * 32 + hi * 16);
                        const bf16x8 fb = *(const LAS bf16x8*)(F.lds + KI + (32 * asb + r32) * 272 + q * 32 + hi * 16);
                        a = MFMA32(fa, fb, a);
                    }
                    const int sg = 32 * asb + r32;
#pragma unroll
                    for (int r = 0; r < 16; ++r) { const int t = 32 * atb + crow(r, hi); ((LAS bf16*)(F.lds + ATT))[t * 72 + sg] = (bf16)f2bf(sg <= t ? a[r] : 0.f); }
                } else if (w >= 4) {
#pragma unroll
                    for (int q = 0; q < 8; ++q) {
                        const bf16x8 fa = *(const LAS bf16x8*)(F.lds + QD + (32 * tb + r32) * 272 + q * 32 + hi * 16);
                        const bf16x8 fb = *(const LAS bf16x8*)(F.lds + ST + (32 * ovb + r32) * 272 + q * 32 + hi * 16);
                        oacc = MFMA32(fa, fb, oacc);
                    }
                }
            }
            __syncthreads();
            if (c >= 4 && w >= 4) {
                const int nss = tb ? 4 : 2;
                for (int q = 0; q < nss; ++q) {
                    const bf16x8 fa = *(const LAS bf16x8*)(F.lds + ATT + (32 * tb + r32) * 144 + q * 32 + hi * 16);
                    const bf16x8 fb = *(const LAS bf16x8*)(F.lds + VT + (32 * ovb + r32) * 144 + q * 32 + hi * 16);
                    oacc = MFMA32(fa, fb, oacc);
                }
#pragma unroll
                for (int r = 0; r < 16; ++r) { const int row = GLA_ROW(c, 32 * tb + crow(r, hi));
                    bf16* dst = (dir ? hg_o1_row(F, row) : O0 + (size_t)row * D) + h * 128 + vh * 64 + 32 * ovb + r32;
                    *dst = (bf16)f2bf(oacc[r]); }
            }
            {
                f32x16 ds = {};
#pragma unroll
                for (int q = 0; q < 4; ++q) {
                    const bf16x8 fa = *(const LAS bf16x8*)(F.lds + KDT + (32 * kb + r32) * 144 + q * 32 + hi * 16);
                    const bf16x8 fb = *(const LAS bf16x8*)(F.lds + VT + (32 * vb + r32) * 144 + q * 32 + hi * 16);
                    ds = MFMA32(fa, fb, ds);
                }
#pragma unroll
                for (int r = 0; r < 16; ++r) S[r] = ((LAS float*)(F.lds + GL))[32 * kb + crow(r, hi)] * S[r] + ds[r];
#pragma unroll
                for (int rg = 0; rg < 4; ++rg) { u32x2 wv; wv.x = pk2(S[4 * rg], S[4 * rg + 1]); wv.y = pk2(S[4 * rg + 2], S[4 * rg + 3]);
                    *(LAS u32x2*)(F.lds + ST + (32 * vb + r32) * 272 + (32 * kb + 8 * rg + 4 * hi) * 2) = wv; }
            }
            if (c + 1 < 68) { GLA_PARK(); if (c + 2 < 68) GLA_LOAD(c + 2); }
            __syncthreads();
        }
#undef GLA_LOAD
#undef GLA_PARK
#undef GLA_ROW
    }
}
__device__ __forceinline__ void hg_readout_phase(Frame& F) {
    const bf16* O0 = (const bf16*)(F.ws + WS_H); const bf16* Gt = (const bf16*)(F.ws + WS_U + 2 * ACT_BYTES);
    bf16* Hout = (bf16*)(F.ws + WS_H);
    const int gw = F.bid * NWAVES + F.wave, NGW = F.G * NWAVES;
    const int c0 = 16 * F.lane;
    for (int row = gw; row < MLAT; row += NGW) {
        const u32x4 a0 = *(const u32x4*)(O0 + (size_t)row * D + c0), a1 = *(const u32x4*)(O0 + (size_t)row * D + c0 + 8);
        const bf16* o1p = hg_o1_row(F, row) + c0;
        const u32x4 b0 = *(const u32x4*)o1p, b1 = *(const u32x4*)(o1p + 8);
        const u32x4 g0 = *(const u32x4*)(Gt + (size_t)row * D + c0), g1 = *(const u32x4*)(Gt + (size_t)row * D + c0 + 8);
        const unsigned aa[8] = {a0.x, a0.y, a0.z, a0.w, a1.x, a1.y, a1.z, a1.w}, bb[8] = {b0.x, b0.y, b0.z, b0.w, b1.x, b1.y, b1.z, b1.w}, gg[8] = {g0.x, g0.y, g0.z, g0.w, g1.x, g1.y, g1.z, g1.w};
        float v[16]; float ss = 0.f;
#pragma unroll
        for (int j = 0; j < 8; ++j) { v[2 * j] = bflo(aa[j]) + bflo(bb[j]); v[2 * j + 1] = bfhi(aa[j]) + bfhi(bb[j]); ss += v[2 * j] * v[2 * j] + v[2 * j + 1] * v[2 * j + 1]; }
        ss += __shfl_xor(ss, 1); ss += __shfl_xor(ss, 2); ss += __shfl_xor(ss, 4);
        const float rstd = rsqrtf(ss * (1.0f / 128.0f) + RMS_EPS);
        unsigned o[8];
#pragma unroll
        for (int j = 0; j < 8; ++j) {
            const float gl = bflo(gg[j]), gh = bfhi(gg[j]);
            const float n0 = INP(35)[(c0 + 2 * j) & 127], n1 = INP(35)[(c0 + 2 * j + 1) & 127];
            o[j] = pk2(v[2 * j] * rstd * n0 * gl * fsigmoid(gl), v[2 * j + 1] * rstd * n1 * gh * fsigmoid(gh));
        }
        *(u32x4*)(Hout + (size_t)row * D + c0) = (u32x4){o[0], o[1], o[2], o[3]};
        *(u32x4*)(Hout + (size_t)row * D + c0 + 8) = (u32x4){o[4], o[5], o[6], o[7]};
    }
}

#define XB_TMO      128
#define XB_XCNT(j)  (256  + 64 * (j))
#define XB_XSUB(j)  (1280 + 64 * (j))
#define XB_XGEN(j)  (2304 + 64 * (j))
#define XB_TOP      3328
#define XB_TOPGEN   3392
#define XCD_BAR_WORDS 3456
#define XB_SPIN_CAP (1u << 18)

__device__ __forceinline__ unsigned xb_ld(unsigned* p)              { return __hip_atomic_load(p, __ATOMIC_RELAXED, __HIP_MEMORY_SCOPE_AGENT); }
__device__ __forceinline__ unsigned xb_add(unsigned* p, unsigned v) { return __hip_atomic_fetch_add(p, v, __ATOMIC_RELAXED, __HIP_MEMORY_SCOPE_AGENT); }
__device__ __forceinline__ unsigned xb_xcc_id() { return (unsigned)__builtin_amdgcn_s_getreg((3 << 11) | 20) & 0xFu; }
#define XB_SPIN(cond, bar) do { unsigned _sp = 0; while (cond) { __builtin_amdgcn_s_sleep(1); \
    if ((++_sp & 255u) == 0u) { if (xb_ld(&(bar)[XB_TMO])) break; if (_sp > XB_SPIN_CAP) { atomicAdd(&(bar)[XB_TMO], 1u); break; } } } } while (0)

struct XcdBarrier {
    unsigned* bar; unsigned x;
    volatile LAS unsigned* st;
};

__device__ __forceinline__ XcdBarrier xcd_barrier_post(unsigned* bar, volatile LAS unsigned* st) {
    XcdBarrier b; b.bar = bar; b.x = xb_xcc_id(); b.st = st;
    if (threadIdx.x == 0) (void)xb_add(&bar[XB_XCNT(b.x)], 1u);
    return b;
}
__device__ __forceinline__ void xcd_barrier_complete(unsigned* bar, unsigned x, unsigned& nloc, unsigned& nx) {
    const unsigned G = gridDim.x * gridDim.y * gridDim.z;
    unsigned sum, cnt, mine, sp = 0u;
    for (;;) {
        sum = 0u; cnt = 0u; mine = 0u;
#pragma unroll
        for (unsigned j = 0; j < 16; ++j) { const unsigned c = xb_ld(&bar[XB_XCNT(j)]); sum += c; cnt += (c > 0u) ? 1u : 0u; mine = (j == x) ? c : mine; }
        if (sum == G) break;
        __builtin_amdgcn_s_sleep(1);
        if ((++sp & 255u) == 0u) { if (xb_ld(&bar[XB_TMO])) break; if (sp > XB_SPIN_CAP) { atomicAdd(&bar[XB_TMO], 1u); break; } }
    }
    nloc = mine > 0u ? mine : 1u; nx = cnt > 0u ? cnt : 1u;
}

__device__ __forceinline__ void xcd_barrier(const XcdBarrier& b) {
    asm volatile("s_waitcnt vmcnt(0)" ::: "memory");
    __syncthreads();
    if (threadIdx.x == 0) {
        unsigned* bar = b.bar;
        __builtin_amdgcn_s_waitcnt(0);
        unsigned nloc = b.st[0], nx = b.st[1];
        if (nloc == 0u) { xcd_barrier_complete(bar, b.x, nloc, nx); b.st[0] = nloc; b.st[1] = nx; }
        const unsigned old = xb_add(&bar[XB_XSUB(b.x)], 1u);
        const unsigned gen = old / nloc;
        if (old + 1u == (gen + 1u) * nloc) {
            __builtin_amdgcn_fence(__ATOMIC_RELEASE, "agent");
            asm volatile("s_waitcnt vmcnt(0)" ::: "memory");
            const unsigned og = xb_add(&bar[XB_TOP], 1u);
            const unsigned tg = og / nx;
            if (og + 1u == (tg + 1u) * nx) xb_add(&bar[XB_TOPGEN], 1u);
            else XB_SPIN(xb_ld(&bar[XB_TOPGEN]) == tg, bar);
            __builtin_amdgcn_fence(__ATOMIC_ACQUIRE, "agent");
            xb_add(&bar[XB_XGEN(b.x)], 1u);
            asm volatile("s_waitcnt vmcnt(0)" ::: "memory");
        } else {
            XB_SPIN(xb_ld(&bar[XB_XGEN(b.x)]) == gen, bar);
            __builtin_amdgcn_fence(__ATOMIC_ACQUIRE, "agent");
            asm volatile("s_waitcnt vmcnt(0)" ::: "memory");
        }
    }
    __syncthreads();
}

#ifndef PHASE_MASK
#define PHASE_MASK 0xffff
#endif
#define PH_ON(op) (((PHASE_MASK) >> (op)) & 1)
enum { OP_NOP = 0, OP_SWIGLU, OP_BF16, OP_NORM, OP_S5A, OP_S5B, OP_S5Z, OP_GLU, OP_QKV_DA, OP_QKV_NA, OP_ATT_DA, OP_ATT_NA, OP_GLA, OP_READOUT };
#define ST(op, sub) ((op) | ((sub) << 4))
#define NOSYNC 256
__device__ const int PROGRAM[4][12] = {
    {ST(OP_SWIGLU, 0), ST(OP_BF16, 0), ST(OP_NORM, 0), ST(OP_S5A, 0), ST(OP_S5B, 0), ST(OP_S5Z, 0), ST(OP_GLU, 0), OP_NOP, ST(OP_NORM, 1), ST(OP_SWIGLU, 1), ST(OP_BF16, 1), ST(OP_NORM, 2)},
    {ST(OP_SWIGLU, 0), ST(OP_BF16, 0), ST(OP_NORM, 0), ST(OP_QKV_DA, 0), ST(OP_ATT_DA, 0), ST(OP_BF16, 2), OP_NOP, OP_NOP, ST(OP_NORM, 1), ST(OP_SWIGLU, 1), ST(OP_BF16, 1), ST(OP_NORM, 2)},
    {ST(OP_SWIGLU, 0), ST(OP_BF16, 0), ST(OP_NORM, 0), ST(OP_QKV_NA, 0), ST(OP_ATT_NA, 0), ST(OP_BF16, 2), OP_NOP, OP_NOP, ST(OP_NORM, 1), ST(OP_SWIGLU, 1), ST(OP_BF16, 1), ST(OP_NORM, 2)},
    {ST(OP_SWIGLU, 0), ST(OP_BF16, 0), ST(OP_NORM, 0), ST(OP_BF16, 3), OP_NOP, ST(OP_GLA, 0), ST(OP_READOUT, 0), ST(OP_BF16, 5), ST(OP_NORM, 1), ST(OP_SWIGLU, 1), ST(OP_BF16, 1), ST(OP_NORM, 2)},
};

#define GSYNC_CG() do { asm volatile("s_waitcnt vmcnt(0) lgkmcnt(0)" ::: "memory"); grid.sync(); __builtin_amdgcn_fence(__ATOMIC_ACQUIRE, "agent"); asm volatile("s_waitcnt vmcnt(0)" ::: "memory"); } while (0)
#define GSYNC() do { XcdBarrier xb_; xb_.bar = (unsigned*)(F.ws + WS_BAR); xb_.x = xb_xcc_id(); xb_.st = (volatile LAS unsigned*)(F.lds + LDS_BYTES - 1024); xcd_barrier(xb_); } while (0)
__global__ void __launch_bounds__(NTHREADS, 2) mega_fwd(Args args) {
    extern __shared__ __attribute__((aligned(16))) unsigned char lds_raw[];
    cg::grid_group grid = cg::this_grid();
    Frame F;
    F.lds = (LAS unsigned char*)lds_raw;
    F.tid = threadIdx.x; F.lane = F.tid & 63; F.wave = __builtin_amdgcn_readfirstlane(F.tid >> 6); F.G = gridDim.x; F.bid = blockIdx.x;
    F.ptab = (LAS unsigned long long*)(F.lds + LDS_BYTES - 512);
#pragma unroll
    for (int i = 0; i < 37; ++i) { if (F.tid == i) F.ptab[i] = (unsigned long long)args.in[i]; }
    F.out = (GAS float*)args.out; F.ws = (GAS unsigned char*)args.ws;
    __syncthreads();

    if (F.tid < 2) ((volatile LAS unsigned*)(F.lds + LDS_BYTES - 1024))[F.tid] = 0u;
    __syncthreads();
    (void)xcd_barrier_post((unsigned*)(F.ws + WS_BAR), (volatile LAS unsigned*)(F.lds + LDS_BYTES - 1024));
#ifdef PROBE_P0
    phase_p0(F);
    GSYNC_CG();
#endif
    phase_p0(F);
    if (F.G == 0x7fffffff) GSYNC_CG();
    GSYNC();
    norm_phase(F, MALL, true, nullptr, nullptr, 0.f, 0, 0, INP(6), 0, 0, false);
    GSYNC();
#ifdef PROBE_SYNCS
#pragma unroll 1
    for (int i = 0; i < PROBE_SYNCS; ++i) GSYNC();
#endif

#pragma unroll 1
    for (int li = 0; li < 4; ++li) {
#pragma unroll 1
        for (int st = 0; st < 12; ++st) {
            const int code = PROGRAM[li][st]; const int op = code & 15, sub = (code >> 4) & 15;
            if (op == OP_NOP) continue;
            const int Mrows = (li == 3 && st >= 7) ? MLAT : MALL;
#ifdef PROBE_DOUBLE
            const int reps = ((PROBE_DOUBLE >> op) & 1) ? 2 : 1;
#else
            const int reps = 1;
#endif
#pragma unroll 1
            for (int rep = 0; rep < reps; ++rep) {
            { GAS unsigned char* w_ = F.ws; GAS float* o_ = F.out; int g_ = F.G, b_ = F.bid, wv_ = F.wave, t_ = F.tid; asm volatile("" : "+s"(w_), "+s"(o_), "+s"(g_), "+s"(b_), "+s"(wv_), "+v"(t_));
              F.ws = w_; F.out = o_;
              F.G = g_; F.bid = b_; F.wave = wv_; F.tid = t_; F.lane = t_ & 63; }
            unsigned char* ws = (unsigned char*)F.ws;
            bf16* Hb = (bf16*)(ws + WS_H); bf16* Ub = (bf16*)(ws + WS_U); bf16* Yb = (bf16*)(ws + WS_Y);
            switch (op) {
            case OP_SWIGLU: if constexpr (PH_ON(OP_SWIGLU)) {
                pg8::Gemm g{Hb, (const bf16*)(ws + (sub ? WS_W13B : WS_W13A)), Mrows, 2 * FF, D}; pg8::StaticOrder S; S.init(Mrows, 2 * FF, F.G, F.bid, D);
                pg8::EpiSwiglu E{Ub};
                pg8::gemm_phase<pg8::EpiSwiglu, pg8::StaticOrder, true, true>(F.lds, g, S, E, F.tid);
            } break;
            case OP_BF16: if constexpr (PH_ON(OP_BF16)) {
                const bf16* A = Hb; const bf16* Bt; int N = D, K = D; bf16 *o0 = Yb, *o1 = Yb, *o2 = Yb, *o3 = Yb, *o4 = Yb; const float* bias = nullptr; int bias_from = 0;
                if (sub == 0) { A = Ub; Bt = (const bf16*)(ws + WS_W2A); K = FF; }
                else if (sub == 1) { A = Ub; Bt = (const bf16*)(ws + WS_W2B); K = FF; }
                else if (sub == 2) { Bt = (const bf16*)(ws + WS_WM) + (size_t)3 * D * D; }
                else if (sub == 3) { Bt = (const bf16*)(ws + WS_WM); N = 5 * D; o0 = Ub; o1 = (bf16*)(ws + WS_U + ACT_BYTES); o2 = (bf16*)(ws + WS_U + 2 * ACT_BYTES);
                                     o3 = (bf16*)(unsigned char*)F.out; o4 = (bf16*)(ws + WS_U + 3 * ACT_BYTES); bias = INP(33); bias_from = 3 * D; }
                else if (sub == 4) { Bt = (const bf16*)(ws + WS_WM) + (size_t)3 * D * D; N = 2 * D; o0 = (bf16*)(unsigned char*)F.out; o1 = (bf16*)(ws + WS_U + 3 * ACT_BYTES); bias = INP(33); }
                else { Bt = (const bf16*)(ws + WS_WM) + (size_t)5 * D * D; }
                const bool split = (Mrows == MALL) && (sub <= 2);
                const pg8::EpiBf16S E{o0, o1, o2, bias, (bf16*)(ws + WS_E), o3, o4, bias_from};
                pg8::Gemm g{A, Bt, Mrows, N, K}; pg8::StaticOrder S;
                if (split) S.init(MLAT, N, F.G, F.bid, K, 2, 32, 128); else S.init(Mrows, N, F.G, F.bid, K);
                pg8::gemm_phase<pg8::EpiBf16S, pg8::StaticOrder, true, true>(F.lds, g, S, E, F.tid);
            } break;
            case OP_GLU: if constexpr (PH_ON(OP_GLU)) {
                pg8::Gemm g{Hb, (const bf16*)(ws + WS_WM), MALL, D, D}; pg8::StaticOrder S; S.init(MALL, D, F.G, F.bid, D);
                pg8::EpiGlu E{Hb, Yb, INP(20)};
                pg8::gemm_phase<pg8::EpiGlu, pg8::StaticOrder, true, true>(F.lds, g, S, E, F.tid);
            } break;
            case OP_QKV_DA: if constexpr (PH_ON(OP_QKV_DA)) {
                pg8::Gemm g{Hb, (const bf16*)(ws + WS_WM), MALL, 3 * D, D}; pg8::StaticOrder S; S.init(MALL, 3 * D, F.G, F.bid, D);
                pg8::EpiQKV<0> E{Ub, (bf16*)(ws + WS_U + ACT_BYTES), (bf16*)(ws + WS_U + 2 * ACT_BYTES), (const float*)(ws + WS_ROPE), (const float*)(ws + WS_ROPE) + 4096 * 32};
                pg8::gemm_phase<pg8::EpiQKV<0>, pg8::StaticOrder, true, true>(F.lds, g, S, E, F.tid);
            } break;
            case OP_QKV_NA: if constexpr (PH_ON(OP_QKV_NA)) {
                pg8::Gemm g{Hb, (const bf16*)(ws + WS_WM), MALL, 3 * D, D}; pg8::StaticOrder S; S.init(MALL, 3 * D, F.G, F.bid, D);
                pg8::EpiQKV<1> E{Ub, (bf16*)(ws + WS_U + ACT_BYTES), (bf16*)(ws + WS_U + 2 * ACT_BYTES), nullptr, nullptr};
                pg8::gemm_phase<pg8::EpiQKV<1>, pg8::StaticOrder, true, true>(F.lds, g, S, E, F.tid);
            } break;
            case OP_NORM: if constexpr (PH_ON(OP_NORM)) {
                const bool last = (li == 3);
                if (sub == 0) norm_phase(F, MALL, false, Yb, INP(7) + (li * 3 + 0) * D, 0.5f, li, 0, INP(6) + (li * 3 + 1) * D, li, 1, false, 2);
                else if (sub == 1) norm_phase(F, last ? MLAT : MALL, false, Yb, INP(7) + (li * 3 + 1) * D, 1.0f, li, 1, INP(6) + (li * 3 + 2) * D, li, 2, false, (li == 1 || li == 2) ? 2 : 0);
                else {
                    if (last) norm_phase(F, MLAT, false, Yb, INP(7) + (li * 3 + 2) * D, 0.5f, li, 2, nullptr, 0, 0, true);
                    else { norm_phase(F, MALL, false, Yb, INP(7) + (li * 3 + 2) * D, 0.5f, li, 2, INP(6) + ((li + 1) * 3 + 0) * D, li + 1, 0, false, 2); __syncthreads(); convert_layer(F, li + 1);
#ifdef PROBE_P0
                        __syncthreads(); convert_layer(F, li + 1);
#endif
                    }
                }
            } break;
            case OP_S5A: if constexpr (PH_ON(OP_S5A)) { s5_pass<false>(F); } break;
            case OP_S5B: if constexpr (PH_ON(OP_S5B)) { s5_pass<true>(F); } break;
            case OP_S5Z: if constexpr (PH_ON(OP_S5Z)) { s5_z_phase(F); } break;
            case OP_ATT_DA: if constexpr (PH_ON(OP_ATT_DA)) { att_da_phase(F); } break;
            case OP_ATT_NA: if constexpr (PH_ON(OP_ATT_NA)) { att_na_phase(F); } break;
            case OP_GLA: if constexpr (PH_ON(OP_GLA)) { gla_phase(F); } break;
            case OP_READOUT: if constexpr (PH_ON(OP_READOUT)) { hg_readout_phase(F); } break;
            default: break;
            }
            if (!(code & NOSYNC)) GSYNC();
            }
#ifdef STOP_AT
            if (li * 12 + st == STOP_AT) {
#ifndef DUMP_KIND
#define DUMP_KIND 0
#define DUMP_OFF WS_X
#define DUMP_N 0
#endif
                if (DUMP_KIND == 0) { const _Float16* X = (const _Float16*)(F.ws + WS_X);
                    for (size_t i = (size_t)F.bid * NTHREADS + F.tid; i < (size_t)MLAT * D; i += (size_t)F.G * NTHREADS) F.out[i] = (float)X[i]; }
                else if (DUMP_KIND == 1) { const bf16* P = (const bf16*)(F.ws + DUMP_OFF);
                    for (size_t i = (size_t)F.bid * NTHREADS + F.tid; i < (size_t)MLAT * D; i += (size_t)F.G * NTHREADS) F.out[i] = bf2f(P[i]); }
                else if (DUMP_KIND == 3) { const bf16* P = (const bf16*)(F.ws + DUMP_OFF); const bf16* P2 = P + (size_t)MALL * D;
                    for (size_t i = (size_t)F.bid * NTHREADS + F.tid; i < (size_t)MLAT * D; i += (size_t)F.G * NTHREADS) F.out[i] = bf2f(P[i]) + bf2f(P2[i]); }
                else { const float* P = (const float*)(F.ws + DUMP_OFF);
                    for (size_t i = (size_t)F.bid * NTHREADS + F.tid; i < (size_t)MLAT * D; i += (size_t)F.G * NTHREADS) F.out[i] = (i < (size_t)DUMP_N) ? P[i] : 0.f; }
                return;
            }
#endif
        }
    }
}

extern "C" void kernel_launch(void* const* d_in, const int* in_sizes, int n_in, void* d_out, int out_size, void* d_ws, size_t ws_size, hipStream_t stream) {
    static int grid = 0;
    if (grid == 0) {
        int dev = 0, cus = 0, per_cu = 0;
        (void)hipGetDevice(&dev);
        (void)hipDeviceGetAttribute(&cus, hipDeviceAttributeMultiprocessorCount, dev);
        if (hipFuncSetAttribute((const void*)mega_fwd, hipFuncAttributeMaxDynamicSharedMemorySize, LDS_BYTES) != hipSuccess) fprintf(stderr, "kernel_launch: hipFuncSetAttribute failed\n");
        if (hipOccupancyMaxActiveBlocksPerMultiprocessor(&per_cu, (const void*)mega_fwd, NTHREADS, LDS_BYTES) != hipSuccess || per_cu < 1) { fprintf(stderr, "kernel_launch: occupancy query gave %d\n", per_cu); per_cu = 1; }
        (void)hipGetLastError();
        if (per_cu > 1) per_cu = 1;
        grid = cus * per_cu;
        if (n_in != 37 || ws_size < WS_NEED) fprintf(stderr, "kernel_launch: n_in %d ws %zu (need %zu)\n", n_in, ws_size, (size_t)WS_NEED);
    }
    (void)hipMemsetAsync((char*)d_ws + WS_BAR, 0, 65536, stream);
    Args a{};
    for (int i = 0; i < 37; ++i) a.in[i] = (const float*)d_in[i];
    a.out = (float*)d_out; a.ws = (unsigned char*)d_ws;
    void* kargs[] = {&a};
    hipError_t e = hipLaunchCooperativeKernel((const void*)mega_fwd, dim3(grid), dim3(NTHREADS), kargs, LDS_BYTES, stream);
    if (e != hipSuccess) fprintf(stderr, "kernel_launch: cooperative launch failed: %s (grid %d)\n", hipGetErrorString(e), grid);
}
```
